# Optimizing an MI355X kernel written in HIP

```python
import jax, jax.numpy as jnp
from jax import lax
import numpy as np

D_MODEL = 2048
BATCH = 4
SEQ = 2048
DEPTH = 2
DEC_BATCH = 128
DEC_SEQ = 8
PAST_LEN = 16384
PAGE_SIZE = 128

HEAD_DIM = 128
POOL_WINDOWS = (2, 4, 8, 16)
N_POOL_GROUPS = len(POOL_WINDOWS)
POOL_WIDTH = D_MODEL // 4
POOL_GROUP_DIM = POOL_WIDTH // N_POOL_GROUPS
POOL_HIST = max(POOL_WINDOWS) - 1
CONV_WIDTH = 3 * D_MODEL // 8
N_CONV_HEADS = CONV_WIDTH // HEAD_DIM
SHORT_CONV = 3
SGU_WIDTH = 3 * D_MODEL // 8
N_SGU_HEADS = SGU_WIDTH // HEAD_DIM
SGU_HEAD_DIM = HEAD_DIM
CHUNK = 128
MIX_WIDTH = POOL_WIDTH + CONV_WIDTH + SGU_WIDTH
IN_WIDTH = POOL_WIDTH + 3 * CONV_WIDTH + 2 * SGU_WIDTH
D_FF = 11 * D_MODEL // 4
FFN_CONV = 3
EPS = 1e-6

kernel_name = "hybrid_pool_shortconv_chunkgmlp_decoder_step"


def rmsnorm(x, g):
    xf = x.astype(jnp.float32)
    y = xf * lax.rsqrt(jnp.mean(xf * xf, axis=-1, keepdims=True) + EPS)
    return (y * g.astype(jnp.float32)).astype(x.dtype)


def causal_conv(z, prev, w):
    k = w.shape[0]
    t = z.shape[1]
    zz = jnp.concatenate([prev, z], axis=1)
    y = sum(w[i] * zz[:, i:i + t] for i in range(k))
    return y, zz[:, -(k - 1):]


def pool_mixer(xa, prev, start, pool_w, pool_scale):
    b, t, p = xa.shape
    zz = jnp.concatenate([prev, xa], axis=1)
    cs = jnp.concatenate([jnp.zeros((b, 1, p), jnp.float32),
                          jnp.cumsum(zz.astype(jnp.float32), axis=1)], axis=1)
    pos = start + jnp.arange(t)
    lo = POOL_HIST + 1
    outs = []
    for g, w in enumerate(POOL_WINDOWS):
        sl = slice(g * POOL_GROUP_DIM, (g + 1) * POOL_GROUP_DIM)
        s = cs[:, lo:lo + t, sl] - cs[:, lo - w:lo - w + t, sl]
        cnt = jnp.minimum(w, pos + 1).astype(jnp.float32)
        outs.append(s / cnt[None, :, None])
    pooled = jnp.stack(outs, axis=2)
    pooled = pooled - xa.astype(jnp.float32).reshape(b, t, N_POOL_GROUPS, POOL_GROUP_DIM)
    y = jnp.einsum('btgc,gcd->btgd', pooled.astype(xa.dtype), pool_w).reshape(b, t, p)
    return y * pool_scale, zz[:, -POOL_HIST:]


def short_conv_mixer(h, bg, cg, prev, conv_w):
    y, new = causal_conv(cg * h, prev, conv_w)
    return bg * y, new


def sgu_mixer(u, v, sgu_norm, sgu_w, sgu_b):
    b, t, s = v.shape
    v = rmsnorm(v, sgu_norm)
    n_chunks = -(-t // CHUNK)
    pad = n_chunks * CHUNK - t
    vp = jnp.pad(v, ((0, 0), (0, pad), (0, 0))).reshape(b, n_chunks, CHUNK, N_SGU_HEADS, SGU_HEAD_DIM)
    mask = jnp.tril(jnp.ones((CHUNK, CHUNK), dtype=bool))
    ws = jnp.where(mask[None], sgu_w, jnp.zeros_like(sgu_w))
    g = jnp.einsum('hqs,bnshd->bnqhd', ws, vp) + sgu_b.T[None, None, :, :, None]
    g = g.reshape(b, n_chunks * CHUNK, s)[:, :t]
    return u * g, v


def conv_ffn(x, prev, up, cw, cb, down):
    a = x @ up
    gate, val = jnp.split(a, 2, axis=-1)
    gc, new = causal_conv(gate, prev, cw)
    h = jax.nn.gelu(gc + cb, approximate=True) * val
    return h @ down, new


def block(x, pool_prev, conv_prev, ffn_prev, start, g_mix_pre, g_mix_post, g_ffn_pre, g_ffn_post,
          w_in, pool_w, pool_scale, conv_w, sgu_norm, sgu_w, sgu_b, w_out,
          ffn_up, ffn_conv_w, ffn_conv_b, ffn_down):
    h = rmsnorm(x, g_mix_pre)
    p = h @ w_in
    o1 = POOL_WIDTH
    o2 = o1 + CONV_WIDTH
    o3 = o2 + CONV_WIDTH
    o4 = o3 + CONV_WIDTH
    o5 = o4 + SGU_WIDTH
    ya, new_pool = pool_mixer(p[..., :o1], pool_prev, start, pool_w, pool_scale)
    yb, new_conv = short_conv_mixer(p[..., o1:o2], p[..., o2:o3], p[..., o3:o4], conv_prev, conv_w)
    yc, v_rows = sgu_mixer(p[..., o4:o5], p[..., o5:], sgu_norm, sgu_w, sgu_b)
    mix = jnp.concatenate([ya, yb, yc], axis=-1) @ w_out
    x = x + rmsnorm(mix, g_mix_post)
    f, new_ffn = conv_ffn(rmsnorm(x, g_ffn_pre), ffn_prev, ffn_up, ffn_conv_w, ffn_conv_b, ffn_down)
    x = x + rmsnorm(f, g_ffn_post)
    return x, new_pool, new_conv, new_ffn, v_rows


def setup_inputs(seed: int = 0) -> dict:
    key = jax.random.key(seed)
    ks = jax.random.split(key, 24)
    f32 = jnp.float32
    nrm = lambda k, shape, scale: (jax.random.normal(k, shape, f32) * scale)
    gain = lambda k, shape: 1.0 + 0.05 * jax.random.normal(k, shape, f32)
    return {
        "x_prompt": nrm(ks[0], (BATCH, SEQ, D_MODEL), 1.0),
        "x_sample": nrm(ks[1], (DEC_BATCH, DEC_SEQ, D_MODEL), 1.0),
        "state_pool": nrm(ks[2], (DEPTH, DEC_BATCH, POOL_HIST, POOL_WIDTH), 1.0),
        "state_conv": nrm(ks[3], (DEPTH, DEC_BATCH, SHORT_CONV - 1, CONV_WIDTH), 1.0),
        "state_ffn": nrm(ks[4], (DEPTH, DEC_BATCH, FFN_CONV - 1, D_FF), 1.0),
        "g_mix_pre": gain(ks[5], (DEPTH, D_MODEL)),
        "g_mix_post": gain(ks[6], (DEPTH, D_MODEL)),
        "g_ffn_pre": gain(ks[7], (DEPTH, D_MODEL)),
        "g_ffn_post": gain(ks[8], (DEPTH, D_MODEL)),
        "w_in": nrm(ks[9], (DEPTH, D_MODEL, IN_WIDTH), D_MODEL ** -0.5),
        "pool_w": nrm(ks[10], (DEPTH, N_POOL_GROUPS, POOL_GROUP_DIM, POOL_GROUP_DIM), POOL_GROUP_DIM ** -0.5),
        "pool_scale": gain(ks[11], (DEPTH, POOL_WIDTH)),
        "conv_w": nrm(ks[12], (DEPTH, SHORT_CONV, CONV_WIDTH), SHORT_CONV ** -0.5),
        "sgu_norm": gain(ks[13], (DEPTH, SGU_WIDTH)),
        "sgu_w": nrm(ks[14], (DEPTH, N_SGU_HEADS, CHUNK, CHUNK), CHUNK ** -0.5),
        "sgu_b": gain(ks[15], (DEPTH, N_SGU_HEADS, CHUNK)),
        "w_out": nrm(ks[16], (DEPTH, MIX_WIDTH, D_MODEL), MIX_WIDTH ** -0.5),
        "ffn_up": nrm(ks[17], (DEPTH, D_MODEL, 2 * D_FF), D_MODEL ** -0.5),
        "ffn_conv_w": nrm(ks[18], (DEPTH, FFN_CONV, D_FF), FFN_CONV ** -0.5),
        "ffn_conv_b": nrm(ks[19], (DEPTH, D_FF), 0.02),
        "ffn_down": nrm(ks[20], (DEPTH, D_FF, D_MODEL), D_FF ** -0.5),
    }


def reference(x_prompt, x_sample, state_pool, state_conv, state_ffn,
              g_mix_pre, g_mix_post, g_ffn_pre, g_ffn_post, w_in, pool_w, pool_scale,
              conv_w, sgu_norm, sgu_w, sgu_b, w_out, ffn_up, ffn_conv_w, ffn_conv_b, ffn_down):
    bp = x_prompt.shape[0]
    dt = x_prompt.dtype
    zero_pool = jnp.zeros((bp, POOL_HIST, POOL_WIDTH), dt)
    zero_conv = jnp.zeros((bp, SHORT_CONV - 1, CONV_WIDTH), dt)
    zero_ffn = jnp.zeros((bp, FFN_CONV - 1, D_FF), dt)
    hp = x_prompt
    hs = x_sample
    pool_p, pool_s, conv_p, conv_s, ffn_p, ffn_s, v_s = [], [], [], [], [], [], []
    for l in range(DEPTH):
        w = (g_mix_pre[l], g_mix_post[l], g_ffn_pre[l], g_ffn_post[l], w_in[l], pool_w[l], pool_scale[l],
             conv_w[l], sgu_norm[l], sgu_w[l], sgu_b[l], w_out[l], ffn_up[l], ffn_conv_w[l],
             ffn_conv_b[l], ffn_down[l])
        hp, np_, nc_, nf_, _ = block(hp, zero_pool, zero_conv, zero_ffn, 0, *w)
        hs, ns_, ncs_, nfs_, vs_ = block(hs, state_pool[l], state_conv[l], state_ffn[l], PAST_LEN, *w)
        pool_p.append(np_)
        conv_p.append(nc_)
        ffn_p.append(nf_)
        pool_s.append(ns_)
        conv_s.append(ncs_)
        ffn_s.append(nfs_)
        v_s.append(vs_)
    return (hp, hs, jnp.stack(pool_p), jnp.stack(pool_s), jnp.stack(conv_p), jnp.stack(conv_s),
            jnp.stack(ffn_p), jnp.stack(ffn_s), jnp.stack(v_s))
```

```cpp
#include <hip/hip_runtime.h>
#include <cstdio>
#include <cstdint>
namespace pg8 {
#define PG8_LAS __attribute__((address_space(3)))
typedef unsigned short bf16_t;
typedef short bf16x8 __attribute__((ext_vector_type(8)));
typedef float f32x4 __attribute__((ext_vector_type(4)));
typedef unsigned u32x4 __attribute__((ext_vector_type(4)));
constexpr int BM = 256, BK = 64, HALF = 128, HTB = HALF * BK * 2  , STAGE_BYTES = 8 * HTB, NXCD = 8, WGM = 8;

__host__ __device__ __forceinline__ int lds_byte(int r, int c) { const int st = (r >> 4) * 2 + (c >> 5), rr = r & 15, cc = c & 31, ob = rr * 64 + cc * 2; return st * 1024 + (ob ^ (((ob >> 9) & 1) << 5)); }
__host__ __device__ __forceinline__ void stage_rc(int b, int& R, int& C) { const int st = b / 1024, sb = b % 1024, swz = sb ^ (((sb >> 9) & 1) << 5); R = (st >> 1) * 16 + swz / 64; C = (st & 1) * 32 + (swz % 64) / 2; }
__host__ __device__ __forceinline__ int perm32(int rho) { const int n = rho >> 4, i = rho & 15; return 8 * (i >> 2) + 4 * n + (i & 3); }

struct Unit { int pm, pn; };
struct Gemm { const bf16_t* A; const bf16_t* Bt; int M, N, K; };

struct StaticOrder {
    int nM, nN, nwg, G, c;
    __host__ __device__ void init(int M, int N, int G_, int c_) { nM = M / BM; nN = N / BM; nwg = nM * nN; G = G_; c = c_; }
    __host__ __device__ bool next(int i, Unit& u) const {
        const long L = (long)i * G + c; if (L >= nwg) return false;
        int wgid = (int)L; { const int q = nwg / NXCD, r = nwg % NXCD, xcd = wgid % NXCD, off = wgid / NXCD; wgid = (xcd < r ? xcd * (q + 1) : r * (q + 1) + (xcd - r) * q) + off; }
        const int nig = WGM * nN, gid = wgid / nig, fm = gid * WGM, gsz = (nM - fm) < WGM ? (nM - fm) : WGM;
        u.pm = fm + ((wgid % nig) % gsz); u.pn = (wgid % nig) / gsz; return true;
    }
    __device__ __forceinline__ void a_ready(const Unit&) const {}
    __device__ __forceinline__ void done(const Unit&) const {}
};

typedef float f32x2c __attribute__((ext_vector_type(2))); typedef __bf16 bf16x2c __attribute__((ext_vector_type(2)));
__device__ __forceinline__ unsigned cvt_pk_bf16(float lo, float hi) { const f32x2c v = {lo, hi}; return __builtin_bit_cast(unsigned, __builtin_convertvector(v, bf16x2c)); }
struct EpiRowScaleBf16 {
    static constexpr bool PERM = true, AFTER_DRAIN = false;
    bf16_t* O; int ldc; const float* rs;
    __device__ __forceinline__ void operator()(const f32x4 (&acc)[2][2][4][2], const Unit& u, int wr, int wc, int fr, int fq) const {
        const int row0 = u.pm * BM + wr * 64 + fr, col0 = u.pn * BM + wc * 32 + 8 * fq;
        float sv[2][4];
#pragma unroll
        for (int ai = 0; ai < 2; ++ai)
#pragma unroll
            for (int m = 0; m < 4; ++m) sv[ai][m] = rs[row0 + ai * HALF + m * 16];
#pragma unroll
        for (int ai = 0; ai < 2; ++ai)
#pragma unroll
            for (int m = 0; m < 4; ++m) { const int r = row0 + ai * HALF + m * 16; const float s = sv[ai][m]; bf16_t* rowp = O + (size_t)r * ldc + col0;
#pragma unroll
                for (int bj = 0; bj < 2; ++bj) { const f32x4 v0 = acc[ai][bj][m][0] * s, v1 = acc[ai][bj][m][1] * s;
                    u32x4 w; w.x = cvt_pk_bf16(v0[0], v0[1]); w.y = cvt_pk_bf16(v0[2], v0[3]); w.z = cvt_pk_bf16(v1[0], v1[1]); w.w = cvt_pk_bf16(v1[2], v1[3]);
                    *(u32x4*)(rowp + bj * HALF) = w; } }
    }
};
struct EpiF32Ssq {
    static constexpr bool PERM = false, AFTER_DRAIN = false;
    float* C; int ldc; float* part;
    __device__ __forceinline__ void operator()(const f32x4 (&acc)[2][2][4][2], const Unit& u, int wr, int wc, int fr, int fq) const {
        const int row0 = u.pm * BM + wr * 64 + fr, col0 = u.pn * BM + wc * 32 + 4 * fq;
#pragma unroll
        for (int ai = 0; ai < 2; ++ai)
#pragma unroll
            for (int m = 0; m < 4; ++m) { const int r = row0 + ai * HALF + m * 16; float* rowp = C + (size_t)r * ldc + col0; float q = 0.f;
#pragma unroll
                for (int bj = 0; bj < 2; ++bj)
#pragma unroll
                    for (int n = 0; n < 2; ++n) { const f32x4 x = acc[ai][bj][m][n]; *(f32x4*)(rowp + bj * HALF + n * 16) = x; q += (x[0] * x[0] + x[1] * x[1]) + (x[2] * x[2] + x[3] * x[3]); }
                q += __shfl_xor(q, 16); q += __shfl_xor(q, 32);
                if (fq == 0) part[(size_t)r * 32 + u.pn * 4 + wc] = q; }
    }
};

template <class Epi, class Sched, bool ALIGN_EPI = false, bool SP2 = false>
__device__ __forceinline__ void gemm_phase(PG8_LAS unsigned char* lds, const Gemm g, const Sched& S, const Epi& E, const int tid_in  ) {
    const int tid = tid_in, wid = __builtin_amdgcn_readfirstlane(tid >> 6), lane = tid & 63, wr = wid >> 2, wc = wid & 3, fr = lane & 15, fq = lane >> 4;
    const int K = g.K, nt = K / BK;
    unsigned voffA[2], voffB[2];
#pragma unroll
    for (int i = 0; i < 2; ++i) { int R, C; stage_rc(tid * 16 + i * 8192, R, C); const int Rb = Epi::PERM ? ((R & ~31) + perm32(R & 31)) : R;
        voffA[i] = (unsigned)(R * K + C) * 2u; voffB[i] = (unsigned)(Rb * K + C) * 2u; }
    const size_t kstep = (size_t)(BK * 2);
    const size_t hstep = (size_t)HALF * K * 2;
    const size_t tstep = 2 * hstep;
    const unsigned ldsw = (unsigned)wid * 1024u;
    const int aoff = lds_byte(wr * 64 + fr, fq * 8), boff = lds_byte(wc * 32 + fr, fq * 8);
#define PG8_SA(b, h) (((b) * 2 + (h)) * HTB)
#define PG8_SB(b, h) ((4 + (b) * 2 + (h)) * HTB)
#define PG8_STAGE(bufoff, gbase, voff) do { _Pragma("unroll") for (int _i = 0; _i < 2; ++_i) \
        __builtin_amdgcn_global_load_lds((const unsigned*)((const char*)(gbase) + (voff)[_i]), (PG8_LAS unsigned*)(lds + (bufoff) + ldsw + _i * 8192), 16, 0, 0); } while (0)
#define PG8_LDA(dst, b, h) do { _Pragma("unroll") for (int m = 0; m < 4; ++m) _Pragma("unroll") for (int k = 0; k < 2; ++k) dst[m][k] = *(const PG8_LAS bf16x8*)(lds + PG8_SA(b, h) + aoff + m * 2048 + k * 1024); } while (0)
#define PG8_LDB(dst, b, h) do { _Pragma("unroll") for (int n = 0; n < 2; ++n) _Pragma("unroll") for (int k = 0; k < 2; ++k) dst[n][k] = *(const PG8_LAS bf16x8*)(lds + PG8_SB(b, h) + boff + n * 2048 + k * 1024); } while (0)
#define PG8_MMA(ai, bj, At, Bt) do { __builtin_amdgcn_s_setprio(1); _Pragma("unroll") for (int m = 0; m < 4; ++m) _Pragma("unroll") for (int n = 0; n < 2; ++n) _Pragma("unroll") for (int k = 0; k < 2; ++k) \
        acc[ai][bj][m][n] = __builtin_amdgcn_mfma_f32_16x16x32_bf16(Bt[n][k], At[m][k], acc[ai][bj][m][n], 0, 0, 0); __builtin_amdgcn_s_setprio(0); } while (0)
#define PG8_WAIT_V(n) asm volatile("s_waitcnt vmcnt(" #n ")" ::: "memory")
#define PG8_WAIT_L(n) asm volatile("s_waitcnt lgkmcnt(" #n ")" ::: "memory")
#define PG8_BAR __builtin_amdgcn_s_barrier()
#define PG8_SCHED __builtin_amdgcn_sched_barrier(0)
    Unit cur, nxt; int ui = 0;
    if (!S.next(0, cur)) return;
    f32x4 acc[2][2][4][2];
#pragma unroll
    for (int a = 0; a < 2; ++a)
#pragma unroll
        for (int b = 0; b < 2; ++b)
#pragma unroll
            for (int m = 0; m < 4; ++m)
#pragma unroll
                for (int n = 0; n < 2; ++n) acc[a][b][m][n] = (f32x4){0.f, 0.f, 0.f, 0.f};
    bf16x8 At[4][2], B0[2][2], B1[2][2];
    const char* cA = (const char*)g.A + (size_t)cur.pm * tstep; const char* cB = (const char*)g.Bt + (size_t)cur.pn * tstep;
    S.a_ready(cur);
    if constexpr (SP2) {
        PG8_STAGE(PG8_SB(0, 0), cB, voffB); PG8_STAGE(PG8_SB(0, 1), cB + hstep, voffB); PG8_STAGE(PG8_SA(0, 0), cA, voffA); PG8_STAGE(PG8_SA(0, 1), cA + hstep, voffA);
        if (wr == 1) PG8_BAR;
        PG8_WAIT_V(2); PG8_BAR;
        PG8_STAGE(PG8_SB(1, 0), cB + kstep, voffB); PG8_STAGE(PG8_SA(1, 0), cA + kstep, voffA); PG8_STAGE(PG8_SB(1, 1), cB + hstep + kstep, voffB);
        PG8_WAIT_V(6); PG8_BAR;
    } else {
        PG8_STAGE(PG8_SB(0, 0), cB, voffB); PG8_STAGE(PG8_SA(0, 0), cA, voffA); PG8_STAGE(PG8_SB(0, 1), cB + hstep, voffB); PG8_STAGE(PG8_SA(0, 1), cA + hstep, voffA);
        if (wr == 1) PG8_BAR;
        PG8_WAIT_V(4); PG8_BAR;
        PG8_STAGE(PG8_SB(1, 0), cB + kstep, voffB); PG8_STAGE(PG8_SA(1, 0), cA + kstep, voffA); PG8_STAGE(PG8_SB(1, 1), cB + hstep + kstep, voffB);
        PG8_WAIT_V(6); PG8_BAR;
    }
    for (;;) {
        const bool has_next = S.next(ui + 1, nxt);
        const char* nA = has_next ? (const char*)g.A + (size_t)nxt.pm * tstep : cA; const char* nB = has_next ? (const char*)g.Bt + (size_t)nxt.pn * tstep : cB;
        for (int t = 0; t < nt; t += 2) {
            const bool last = (t == nt - 2);
            const char* a1 = cA + (size_t)(t + 1) * kstep;
            const char* a2 = last ? nA : cA + (size_t)(t + 2) * kstep; const char* b2 = last ? nB : cB + (size_t)(t + 2) * kstep;
            const char* a3 = a2 + kstep; const char* b3 = b2 + kstep;
            if (last && has_next) S.a_ready(nxt);
            if constexpr (SP2) {
            PG8_LDB(B0, 0, 0); PG8_LDB(B1, 0, 1); PG8_SCHED; PG8_LDA(At, 0, 0); PG8_STAGE(PG8_SA(1, 1), a1 + hstep, voffA);
            PG8_WAIT_V(8); PG8_WAIT_L(0); PG8_BAR; PG8_MMA(0, 0, At, B0); PG8_MMA(0, 1, At, B1); PG8_BAR; PG8_SCHED;
            PG8_LDA(At, 0, 1); PG8_STAGE(PG8_SB(0, 0), b2, voffB); PG8_STAGE(PG8_SB(0, 1), b2 + hstep, voffB); PG8_STAGE(PG8_SA(0, 0), a2, voffA);
            PG8_WAIT_V(8); PG8_WAIT_L(0); PG8_BAR; PG8_MMA(1, 0, At, B0); PG8_MMA(1, 1, At, B1); PG8_BAR; PG8_SCHED;
            PG8_LDB(B0, 1, 0); PG8_LDB(B1, 1, 1); PG8_SCHED; PG8_LDA(At, 1, 0); PG8_STAGE(PG8_SA(0, 1), a2 + hstep, voffA);
            PG8_WAIT_V(8); PG8_WAIT_L(0); PG8_BAR; PG8_MMA(0, 0, At, B0); PG8_MMA(0, 1, At, B1); PG8_BAR; PG8_SCHED;
            PG8_LDA(At, 1, 1); PG8_STAGE(PG8_SB(1, 0), b3, voffB); PG8_STAGE(PG8_SB(1, 1), b3 + hstep, voffB); PG8_STAGE(PG8_SA(1, 0), a3, voffA);
            PG8_WAIT_V(8); PG8_WAIT_L(0); PG8_BAR; PG8_MMA(1, 0, At, B0); PG8_MMA(1, 1, At, B1); PG8_BAR; PG8_SCHED;
            } else {
            PG8_LDB(B0, 0, 0); PG8_SCHED; PG8_LDA(At, 0, 0); PG8_STAGE(PG8_SA(1, 1), a1 + hstep, voffA);
            PG8_WAIT_L(8); PG8_BAR; PG8_WAIT_L(0); PG8_MMA(0, 0, At, B0); PG8_BAR; PG8_SCHED;
            PG8_LDB(B1, 0, 1); PG8_STAGE(PG8_SB(0, 0), b2, voffB);
            PG8_BAR; PG8_WAIT_L(0); PG8_MMA(0, 1, At, B1); PG8_BAR;
            PG8_LDA(At, 0, 1); PG8_STAGE(PG8_SA(0, 0), a2, voffA);
            PG8_BAR; PG8_WAIT_L(0); PG8_MMA(1, 0, At, B0); PG8_BAR; PG8_SCHED;
            PG8_STAGE(PG8_SB(0, 1), b2 + hstep, voffB);
            PG8_WAIT_V(6); PG8_BAR; PG8_MMA(1, 1, At, B1); PG8_BAR;
            PG8_LDB(B0, 1, 0); PG8_SCHED; PG8_LDA(At, 1, 0); PG8_STAGE(PG8_SA(0, 1), a2 + hstep, voffA);
            PG8_WAIT_L(8); PG8_BAR; PG8_WAIT_L(0); PG8_MMA(0, 0, At, B0); PG8_BAR; PG8_SCHED;
            PG8_LDB(B1, 1, 1); PG8_STAGE(PG8_SB(1, 0), b3, voffB);
            PG8_BAR; PG8_WAIT_L(0); PG8_MMA(0, 1, At, B1); PG8_BAR;
            PG8_LDA(At, 1, 1); PG8_STAGE(PG8_SA(1, 0), a3, voffA);
            PG8_BAR; PG8_WAIT_L(0); PG8_MMA(1, 0, At, B0); PG8_BAR; PG8_SCHED;
            PG8_STAGE(PG8_SB(1, 1), b3 + hstep, voffB);
            PG8_WAIT_V(6); PG8_BAR; PG8_MMA(1, 1, At, B1); PG8_BAR;
            }
        }
        if constexpr (ALIGN_EPI) { if (wr == 0) PG8_BAR; }
        if constexpr (!Epi::AFTER_DRAIN) { E(acc, cur, wr, wc, fr, fq); S.done(cur); }
        if (!has_next) break;
#pragma unroll
        for (int a = 0; a < 2; ++a)
#pragma unroll
            for (int b = 0; b < 2; ++b)
#pragma unroll
                for (int m = 0; m < 4; ++m)
#pragma unroll
                    for (int n = 0; n < 2; ++n) acc[a][b][m][n] = (f32x4){0.f, 0.f, 0.f, 0.f};
        cur = nxt; cA = nA; cB = nB; ++ui;
        if constexpr (ALIGN_EPI) { if (wr == 1) PG8_BAR; }
    }
    PG8_WAIT_V(0);
    if constexpr (!ALIGN_EPI) { if (wr == 0) PG8_BAR; }
    PG8_BAR;
    if constexpr (Epi::AFTER_DRAIN) { E.fused(acc, cur, wr, wc, fr, fq, lds, wid, lane); S.done(cur); }
#undef PG8_SA
#undef PG8_SB
#undef PG8_STAGE
#undef PG8_LDA
#undef PG8_LDB
#undef PG8_MMA
#undef PG8_WAIT_V
#undef PG8_WAIT_L
#undef PG8_BAR
#undef PG8_SCHED
}
}
#define GAS __attribute__((address_space(1)))
#define LAS __attribute__((address_space(3)))
typedef unsigned short bf16;
typedef unsigned v4u __attribute__((ext_vector_type(4)));
typedef float f32x4 __attribute__((ext_vector_type(4)));
typedef short bf16x8 __attribute__((ext_vector_type(8)));
typedef GAS unsigned gu32;
typedef GAS unsigned long long gu64;
#define RLX_AGENT __ATOMIC_RELAXED, __HIP_MEMORY_SCOPE_AGENT
#define LDS_WAIT() asm volatile("s_waitcnt lgkmcnt(0)" ::: "memory")
#define VM_WAIT() asm volatile("s_waitcnt vmcnt(0)" ::: "memory")
__device__ __forceinline__ unsigned long long rt() { return __builtin_amdgcn_s_memrealtime(); }
__device__ __forceinline__ unsigned pk2(float lo, float hi) { return pg8::cvt_pk_bf16(lo, hi); }
__device__ __forceinline__ unsigned f2bf(float f) { return pg8::cvt_pk_bf16(f, 0.f) & 0xffffu; }

#define XB_TMO      128
#define XB_XCNT(j)  (256  + 64 * (j))
#define XB_XSUB(j)  (1280 + 64 * (j))
#define XB_XGEN(j)  (2304 + 64 * (j))
#define XB_TOP      3328
#define XB_TOPGEN   3392
#define XCD_BAR_WORDS 3456
#define XB_SPIN_CAP (1u << 18)

__device__ __forceinline__ unsigned xb_ld(unsigned* p)              { return __hip_atomic_load(p, __ATOMIC_RELAXED, __HIP_MEMORY_SCOPE_AGENT); }
__device__ __forceinline__ unsigned xb_add(unsigned* p, unsigned v) { return __hip_atomic_fetch_add(p, v, __ATOMIC_RELAXED, __HIP_MEMORY_SCOPE_AGENT); }
__device__ __forceinline__ unsigned xb_xcc_id() { return (unsigned)__builtin_amdgcn_s_getreg((3 << 11) | 20) & 0xFu; }
#define XB_SPIN(cond, bar) do { unsigned _sp = 0; while (cond) { __builtin_amdgcn_s_sleep(1); \
    if ((++_sp & 255u) == 0u) { if (xb_ld(&(bar)[XB_TMO])) break; if (_sp > XB_SPIN_CAP) { atomicAdd(&(bar)[XB_TMO], 1u); break; } } } } while (0)

struct XcdBarrier {
    unsigned* bar; unsigned x;
    volatile LAS unsigned* st;
};

__device__ __forceinline__ XcdBarrier xcd_barrier_post(unsigned* bar, volatile LAS unsigned* st) {
    XcdBarrier b; b.bar = bar; b.x = xb_xcc_id(); b.st = st;
    if (threadIdx.x == 0) (void)xb_add(&bar[XB_XCNT(b.x)], 1u);
    return b;
}
__device__ __forceinline__ void xcd_barrier_complete(unsigned* bar, unsigned x, unsigned& nloc, unsigned& nx) {
    const unsigned G = gridDim.x * gridDim.y * gridDim.z;
    unsigned sum, cnt, mine, sp = 0u;
    for (;;) {
        sum = 0u; cnt = 0u; mine = 0u;
#pragma unroll
        for (unsigned j = 0; j < 16; ++j) { const unsigned c = xb_ld(&bar[XB_XCNT(j)]); sum += c; cnt += (c > 0u) ? 1u : 0u; mine = (j == x) ? c : mine; }
        if (sum == G) break;
        __builtin_amdgcn_s_sleep(1);
        if ((++sp & 255u) == 0u) { if (xb_ld(&bar[XB_TMO])) break; if (sp > XB_SPIN_CAP) { atomicAdd(&bar[XB_TMO], 1u); break; } }
    }
    nloc = mine > 0u ? mine : 1u; nx = cnt > 0u ? cnt : 1u;
}

__device__ __forceinline__ void xcd_barrier(const XcdBarrier& b) {
    asm volatile("s_waitcnt vmcnt(0)" ::: "memory");
    __syncthreads();
    if (threadIdx.x == 0) {
        unsigned* bar = b.bar;
        __builtin_amdgcn_s_waitcnt(0);
        unsigned nloc = b.st[0], nx = b.st[1];
        if (nloc == 0u) { xcd_barrier_complete(bar, b.x, nloc, nx); b.st[0] = nloc; b.st[1] = nx; }
        const unsigned old = xb_add(&bar[XB_XSUB(b.x)], 1u);
        const unsigned gen = old / nloc;
        if (old + 1u == (gen + 1u) * nloc) {
            __builtin_amdgcn_fence(__ATOMIC_RELEASE, "agent");
            asm volatile("s_waitcnt vmcnt(0)" ::: "memory");
            const unsigned og = xb_add(&bar[XB_TOP], 1u);
            const unsigned tg = og / nx;
            if (og + 1u == (tg + 1u) * nx) xb_add(&bar[XB_TOPGEN], 1u);
            else XB_SPIN(xb_ld(&bar[XB_TOPGEN]) == tg, bar);
            __builtin_amdgcn_fence(__ATOMIC_ACQUIRE, "agent");
            xb_add(&bar[XB_XGEN(b.x)], 1u);
            asm volatile("s_waitcnt vmcnt(0)" ::: "memory");
        } else {
            XB_SPIN(xb_ld(&bar[XB_XGEN(b.x)]) == gen, bar);
            __builtin_amdgcn_fence(__ATOMIC_ACQUIRE, "agent");
            asm volatile("s_waitcnt vmcnt(0)" ::: "memory");
        }
    }
    __syncthreads();
}

#ifndef MK_PER_PHASE
#define MK_PER_PHASE 1
#endif
constexpr int NWAVES = 8, NTHR = NWAVES * 64;
constexpr int DM = 2048, MP = 8192, MS = 1024, MTOT = MP + MS, SEQ = 2048, NBAT = 4, DBAT = 128, DSEQ = 8, DEPTH = 2;
constexpr int PW = 512, CW = 768, SW = 768, INW = 4352, FF = 5632, FF2 = 2 * FF, PHIST = 15;
constexpr int O1 = 512, O2 = 1280, O3 = 2048, O4 = 2816, O5 = 3584;
constexpr float EPS = 1e-6f;
constexpr int NPHASE = 1 + 8 * DEPTH;
constexpr size_t OUT_POOLP = (size_t)MTOT * DM, OUT_POOLS = OUT_POOLP + (size_t)DEPTH * NBAT * PHIST * PW, OUT_CONVP = OUT_POOLS + (size_t)DEPTH * DBAT * PHIST * PW,
                 OUT_CONVS = OUT_CONVP + (size_t)DEPTH * NBAT * 2 * CW, OUT_FFNP = OUT_CONVS + (size_t)DEPTH * DBAT * 2 * CW, OUT_FFNS = OUT_FFNP + (size_t)DEPTH * NBAT * 2 * FF,
                 OUT_VS = OUT_FFNS + (size_t)DEPTH * DBAT * 2 * FF, OUT_END = OUT_VS + (size_t)DEPTH * DBAT * DSEQ * SW;
static_assert(OUT_END == 25853952, "d_out map");
constexpr size_t MiB = 1u << 20;
constexpr size_t WS_CTL = 0, CTL_ZERO_BYTES = 1 * MiB;
constexpr size_t WS_WIN = 1 * MiB, WIN_L = 17 * MiB, WS_WOUT = 35 * MiB, WOUT_L = 8 * MiB, WS_WUP = 51 * MiB, WUP_L = 44 * MiB, WS_WDN = 139 * MiB, WDN_L = 22 * MiB;
constexpr size_t WS_SGUW = 183 * MiB, WS_RINV = 184 * MiB, WS_SSQP = 185 * MiB, WS_XB = 187 * MiB, WS_MIX = 223 * MiB, WS_R1 = 295 * MiB, WS_R2 = 493 * MiB, WS_END = 592 * MiB;
static_assert((size_t)INW * DM * 2 == WIN_L && (size_t)DM * DM * 2 == WOUT_L && (size_t)FF2 * DM * 2 == WUP_L && (size_t)DM * FF * 2 == WDN_L, "weight copies");
static_assert((size_t)MTOT * DM * 2 == 36 * MiB && (size_t)MTOT * DM * 4 == 72 * MiB && (size_t)MTOT * FF2 * 2 == 198 * MiB && (size_t)MTOT * FF * 2 == 99 * MiB, "activation buffers");
constexpr int CW_BAR = 4096;
constexpr int RING_OFF = 0, RING_BYTES = 131072, LDSCTL_OFF = RING_BYTES, MISC_OFF = LDSCTL_OFF + 320, LDS_BYTES = 147456;

struct Args {
    const float *x_prompt, *x_sample, *state_pool, *state_conv, *state_ffn, *g_mix_pre, *g_mix_post, *g_ffn_pre, *g_ffn_post, *w_in, *pool_w, *pool_scale, *conv_w, *sgu_norm, *sgu_w, *sgu_b, *w_out,
        *ffn_up, *ffn_conv_w, *ffn_conv_b, *ffn_down;
    float* out; unsigned char* ws; int ph_lo, ph_hi;
};

typedef const __attribute__((address_space(4))) Args* ArgsP;
__device__ __forceinline__ ArgsP launder(ArgsP p) { asm volatile("" : "+s"(p)); return p; }

__device__ __forceinline__ float wave_sum(float v) {
#pragma unroll
    for (int o = 1; o < 64; o <<= 1) v += __shfl_xor(v, o);
    return v;
}
__device__ __forceinline__ float bflo(unsigned w) { return __builtin_bit_cast(float, w << 16); }
__device__ __forceinline__ float bfhi(unsigned w) { return __builtin_bit_cast(float, w & 0xffff0000u); }
__device__ __forceinline__ float bf1(bf16 b) { return __builtin_bit_cast(float, ((unsigned)b) << 16); }
__device__ __forceinline__ void unpack8(const v4u r, float (&f)[8]) { f[0] = bflo(r.x); f[1] = bfhi(r.x); f[2] = bflo(r.y); f[3] = bfhi(r.y); f[4] = bflo(r.z); f[5] = bfhi(r.z); f[6] = bflo(r.w); f[7] = bfhi(r.w); }
__device__ __forceinline__ v4u pack8(const float (&f)[8]) { v4u o; o.x = pk2(f[0], f[1]); o.y = pk2(f[2], f[3]); o.z = pk2(f[4], f[5]); o.w = pk2(f[6], f[7]); return o; }
__device__ __forceinline__ void ld8f(const float* p, float (&f)[8]) { const f32x4 a = *(const f32x4*)p, b = *(const f32x4*)(p + 4); f[0] = a.x; f[1] = a.y; f[2] = a.z; f[3] = a.w; f[4] = b.x; f[5] = b.y; f[6] = b.z; f[7] = b.w; }
__device__ __forceinline__ void st8f(float* p, const float (&f)[8]) { *(f32x4*)p = (f32x4){f[0], f[1], f[2], f[3]}; *(f32x4*)(p + 4) = (f32x4){f[4], f[5], f[6], f[7]}; }

__device__ __forceinline__ void p0_transpose_item(const float* W, int ldw, const float* gain, bf16* WT, int ldk, LAS float* scr, int k0, int n0, int lane) {
#pragma unroll 8
    for (int i = 0; i < 32; ++i) { const int kk = 2 * i + (lane >> 5); float v = W[(size_t)(k0 + kk) * ldw + n0 + (lane & 31)]; if (gain) v *= gain[k0 + kk]; scr[kk * 33 + (lane & 31)] = v; }
    LDS_WAIT(); asm volatile("" ::: "memory");
    const int c = lane & 7;
#pragma unroll
    for (int j = 0; j < 4; ++j) { const int n = (lane >> 3) + 8 * j; const LAS float* s = scr + (8 * c) * 33 + n;
        v4u o; o.x = pk2(s[0 * 33], s[1 * 33]); o.y = pk2(s[2 * 33], s[3 * 33]); o.z = pk2(s[4 * 33], s[5 * 33]); o.w = pk2(s[6 * 33], s[7 * 33]);
        *(GAS v4u*)(WT + (size_t)(n0 + n) * ldk + k0 + 8 * c) = o; }
    LDS_WAIT(); asm volatile("" ::: "memory");
}
__device__ __forceinline__ void x_row_to_bf16(const float* xrow, bf16* orow, float* rinv, int lane) {
    const f32x4* xr = (const f32x4*)xrow + lane; f32x4 v[8]; float s = 0.f;
#pragma unroll
    for (int j = 0; j < 8; ++j) { v[j] = xr[64 * j]; s += (v[j].x * v[j].x + v[j].y * v[j].y) + (v[j].z * v[j].z + v[j].w * v[j].w); }
    s = wave_sum(s);
    unsigned long long* o8 = (unsigned long long*)orow + lane;
#pragma unroll
    for (int j = 0; j < 8; ++j) o8[64 * j] = (unsigned long long)pk2(v[j].x, v[j].y) | ((unsigned long long)pk2(v[j].z, v[j].w) << 32);
    if (lane == 0) *rinv = rsqrtf(s * (1.f / DM) + EPS);
}
__device__ __forceinline__ void p0_prologue(ArgsP AP, LAS unsigned char* lds, int tid, int lane, int wave, int vb, int G) {
    unsigned char* ws = AP->ws;
    LAS float* scr = (LAS float*)(lds + RING_OFF + wave * 16384);
    const int gw = vb * NWAVES + wave, NGW = G * NWAVES;
    constexpr int I_IN = (DM / 64) * (INW / 32), I_OUT = ((DM - PW) / 64) * (DM / 32), I_UP = (DM / 64) * (FF2 / 32), I_DN = (FF / 64) * (DM / 32), I_L = I_IN + I_OUT + I_UP + I_DN;
    for (int it = gw; it < DEPTH * I_L; it += NGW) {
        const int l = it / I_L; int r = it % I_L;
        if (r < I_IN) { const int nb = INW / 32; p0_transpose_item(AP->w_in + (size_t)l * DM * INW, INW, AP->g_mix_pre + l * DM, (bf16*)(ws + WS_WIN + l * WIN_L), DM, scr, 64 * (r / nb), 32 * (r % nb), lane); continue; } r -= I_IN;
        if (r < I_OUT) { const int nb = DM / 32; p0_transpose_item(AP->w_out + (size_t)l * DM * DM, DM, nullptr, (bf16*)(ws + WS_WOUT + l * WOUT_L), DM, scr, PW + 64 * (r / nb), 32 * (r % nb), lane); continue; } r -= I_OUT;
        if (r < I_UP) { const int nb = FF2 / 32; p0_transpose_item(AP->ffn_up + (size_t)l * DM * FF2, FF2, AP->g_ffn_pre + l * DM, (bf16*)(ws + WS_WUP + l * WUP_L), DM, scr, 64 * (r / nb), 32 * (r % nb), lane); continue; } r -= I_UP;
        { const int nb = DM / 32; p0_transpose_item(AP->ffn_down + (size_t)l * FF * DM, DM, nullptr, (bf16*)(ws + WS_WDN + l * WDN_L), FF, scr, 64 * (r / nb), 32 * (r % nb), lane); }
    }
    for (int it = gw; it < DEPTH * 64 * 32; it += NGW) {
        const int l = it / 2048, kg = (it % 2048) / 32, nb = it % 32, g = kg >> 4, c0 = (kg & 15) * 8, n = nb * 64 + lane;
        const float* wo = AP->w_out + (size_t)l * DM * DM + (size_t)(g * 128) * DM + n; const float* pw = AP->pool_w + ((size_t)(l * 4 + g) * 128 + c0) * 128; const float* sc = AP->pool_scale + l * PW + g * 128;
        float acc[8];
#pragma unroll
        for (int j = 0; j < 8; ++j) acc[j] = 0.f;
#pragma unroll 4
        for (int d = 0; d < 128; ++d) { const float wv = wo[(size_t)d * DM] * sc[d];
#pragma unroll
            for (int j = 0; j < 8; ++j) acc[j] += pw[j * 128 + d] * wv; }
        *(GAS v4u*)((bf16*)(ws + WS_WOUT + l * WOUT_L) + (size_t)n * DM + kg * 8) = pack8(acc);
    }
    { bf16* sw = (bf16*)(ws + WS_SGUW);
      for (int i = vb * NTHR + tid; i < DEPTH * 6 * 128 * 128; i += G * NTHR) { const int q = (i >> 7) & 127, s = i & 127; sw[i] = (bf16)(s <= q ? f2bf(AP->sgu_w[i]) : 0u); } }
    for (int m = gw; m < MTOT; m += NGW) { const float* src = m < MP ? AP->x_prompt + (size_t)m * DM : AP->x_sample + (size_t)(m - MP) * DM;
        x_row_to_bf16(src, (bf16*)(ws + WS_XB) + (size_t)m * DM, (float*)(ws + WS_RINV) + m, lane); }
}

__device__ __forceinline__ float v_row_rinv(const bf16* Pb, int row, int lane) {
    const uint2* src = (const uint2*)(Pb + (size_t)row * INW + O5 + lane * 12); float q = 0.f;
#pragma unroll
    for (int i = 0; i < 3; ++i) { const uint2 a = src[i]; const float f0 = bflo(a.x), f1 = bfhi(a.x), f2 = bflo(a.y), f3 = bfhi(a.y); q += (f0 * f0 + f1 * f1) + (f2 * f2 + f3 * f3); }
    q = wave_sum(q);
    return rsqrtf(q * (1.f / SW) + EPS);
}
template <int WIN> __device__ __forceinline__ void pool_item(ArgsP AP, const bf16* Pb, bf16* MC, int l, int m, int c0) {
    float s[8];
#pragma unroll
    for (int e = 0; e < 8; ++e) s[e] = 0.f;
    float cnt; float cur[8];
    if (m < MP) {
        const int t = m & (SEQ - 1); cnt = (float)(t + 1 < WIN ? t + 1 : WIN);
#pragma unroll
        for (int j = 0; j < WIN; ++j) { const bool ok = t - j >= 0; const int row = ok ? m - j : m; float f[8]; unpack8(*(const v4u*)(Pb + (size_t)row * INW + c0), f); const float k = ok ? 1.f : 0.f;
            if (j == 0) {
#pragma unroll
                for (int e = 0; e < 8; ++e) cur[e] = f[e]; }
#pragma unroll
            for (int e = 0; e < 8; ++e) s[e] += k * f[e]; }
    } else {
        const int si = (m - MP) >> 3, t = (m - MP) & 7; cnt = (float)WIN; const float* prev = AP->state_pool + ((size_t)(l * DBAT + si) * PHIST) * PW + c0;
#pragma unroll
        for (int j = 0; j < WIN; ++j) { const int tt = t - j; const bool ok = tt >= 0; const int row = ok ? m - j : m; float f[8], g[8]; unpack8(*(const v4u*)(Pb + (size_t)row * INW + c0), f);
            int pr = PHIST + tt; pr = pr < 0 ? 0 : (pr > PHIST - 1 ? PHIST - 1 : pr); ld8f(prev + (size_t)pr * PW, g);
            if (j == 0) {
#pragma unroll
                for (int e = 0; e < 8; ++e) cur[e] = f[e]; }
#pragma unroll
            for (int e = 0; e < 8; ++e) s[e] += ok ? f[e] : g[e]; }
    }
    const float ic = 1.f / cnt; float o[8];
#pragma unroll
    for (int e = 0; e < 8; ++e) o[e] = s[e] * ic - cur[e];
    *(v4u*)(MC + (size_t)m * DM + c0) = pack8(o);
}
__device__ __forceinline__ void conv_z(ArgsP AP, const bf16* Pb, int l, int m, int j, int c0, float (&z)[8]) {
    int t, si = 0; const bool samp = m >= MP; if (!samp) t = m & (SEQ - 1); else { si = (m - MP) >> 3; t = (m - MP) & 7; }
    const int tt = t - 2 + j; const bool ok = tt >= 0; const int row = ok ? m - 2 + j : m;
    float a[8], b[8]; unpack8(*(const v4u*)(Pb + (size_t)row * INW + O3 + c0), a); unpack8(*(const v4u*)(Pb + (size_t)row * INW + O1 + c0), b);
    if (samp) { float g[8]; int pr = 2 + tt; pr = pr < 0 ? 0 : (pr > 1 ? 1 : pr); ld8f(AP->state_conv + ((size_t)(l * DBAT + si) * 2 + pr) * CW + c0, g);
#pragma unroll
        for (int e = 0; e < 8; ++e) z[e] = ok ? a[e] * b[e] : g[e]; }
    else {
#pragma unroll
        for (int e = 0; e < 8; ++e) z[e] = ok ? a[e] * b[e] : 0.f; }
}
__device__ __forceinline__ void phase_mixers(ArgsP AP, int l, LAS unsigned char* lds, int tid, int lane, int wave, int vb, int G) {
    unsigned char* ws = AP->ws; const bf16* Pb = (const bf16*)(ws + WS_R1); bf16* MC = (bf16*)(ws + WS_R2); const bf16* SGW = (const bf16*)(ws + WS_SGUW);
    LAS float* rv = (LAS float*)lds; LAS bf16* vnT = (LAS bf16*)(lds + 512); constexpr int LDV = 136;
    constexpr int U_SP = (MP / 128) * 6, U_SS = DBAT, U_PC = MTOT / 32, NU = U_SP + U_SS + U_PC;
    for (int u = vb; u < NU; u += G) {
        if (u < U_SP) {
            const int cidx = u / 6, h = u % 6, r0 = cidx * 128;
            for (int i = 0; i < 16; ++i) { const float r = v_row_rinv(Pb, r0 + wave * 16 + i, lane); if (lane == 0) rv[wave * 16 + i] = r; }
            __syncthreads();
#pragma unroll
            for (int i = 0; i < 4; ++i) { const int vec = tid + NTHR * i, s = vec & 127, d0 = (vec >> 7) * 8; float f[8], nr[8];
                unpack8(*(const v4u*)(Pb + (size_t)(r0 + s) * INW + O5 + h * 128 + d0), f); ld8f(AP->sgu_norm + l * SW + h * 128 + d0, nr); const float rs = rv[s];
#pragma unroll
                for (int e = 0; e < 8; ++e) vnT[(d0 + e) * LDV + s] = (bf16)f2bf(f[e] * rs * nr[e]); }
            __syncthreads();
            const int wq = wave >> 1, wd = wave & 1, fr = lane & 15, fq = lane >> 4;
            f32x4 acc[2][4];
#pragma unroll
            for (int mi = 0; mi < 2; ++mi)
#pragma unroll
                for (int ni = 0; ni < 4; ++ni) acc[mi][ni] = (f32x4){0.f, 0.f, 0.f, 0.f};
            const bf16* Wg = SGW + (size_t)(l * 6 + h) * 128 * 128;
            for (int ks = 0; ks <= wq; ++ks) {
                bf16x8 a[2], b[4];
#pragma unroll
                for (int mi = 0; mi < 2; ++mi) a[mi] = *(const bf16x8*)(Wg + (size_t)(32 * wq + 16 * mi + fr) * 128 + 32 * ks + 8 * fq);
#pragma unroll
                for (int ni = 0; ni < 4; ++ni) b[ni] = *(const LAS bf16x8*)(vnT + (64 * wd + 16 * ni + fr) * LDV + 32 * ks + 8 * fq);
#pragma unroll
                for (int mi = 0; mi < 2; ++mi)
#pragma unroll
                    for (int ni = 0; ni < 4; ++ni) acc[mi][ni] = __builtin_amdgcn_mfma_f32_16x16x32_bf16(a[mi], b[ni], acc[mi][ni], 0, 0, 0);
            }
#pragma unroll
            for (int mi = 0; mi < 2; ++mi)
#pragma unroll
                for (int j = 0; j < 4; ++j) { const int q = 32 * wq + 16 * mi + 4 * fq + j, m = r0 + q; const float bq = AP->sgu_b[(l * 6 + h) * 128 + q];
#pragma unroll
                    for (int ni = 0; ni < 4; ++ni) { const int d = 64 * wd + 16 * ni + fr; const float uu = bf1(Pb[(size_t)m * INW + O4 + h * 128 + d]);
                        MC[(size_t)m * DM + O2 + h * 128 + d] = (bf16)f2bf(uu * (acc[mi][ni][j] + bq)); } }
            __syncthreads();
        } else if (u < U_SP + U_SS) {
            const int si = u - U_SP, r0 = MP + 8 * si;
            { const float r = v_row_rinv(Pb, r0 + wave, lane); if (lane == 0) rv[wave] = r; }
            __syncthreads();
            for (int c = tid; c < SW; c += NTHR) { const int h = c >> 7; float vn[8]; const float nr = AP->sgu_norm[l * SW + c];
#pragma unroll
                for (int t = 0; t < 8; ++t) { vn[t] = bf1(Pb[(size_t)(r0 + t) * INW + O5 + c]) * rv[t] * nr; AP->out[OUT_VS + ((size_t)(l * DBAT + si) * DSEQ + t) * SW + c] = vn[t]; }
#pragma unroll
                for (int q = 0; q < 8; ++q) { float gq = AP->sgu_b[(l * 6 + h) * 128 + q]; const float* wrow = AP->sgu_w + ((size_t)(l * 6 + h) * 128 + q) * 128;
#pragma unroll
                    for (int t = 0; t < 8; ++t) if (t <= q) gq += wrow[t] * vn[t];
                    const float uu = bf1(Pb[(size_t)(r0 + q) * INW + O4 + c]); MC[(size_t)(r0 + q) * DM + O2 + c] = (bf16)f2bf(uu * gq); } }
            __syncthreads();
        } else {
            const int r0 = (u - U_SP - U_SS) * 32;
            { const int g = wave & 3;
              for (int i = 0; i < 4; ++i) { const int rq = (wave >> 2) + 2 * i, m = r0 + 4 * rq + (lane >> 4), c0 = (g * 16 + (lane & 15)) * 8;
                  if (g == 0) pool_item<2>(AP, Pb, MC, l, m, c0); else if (g == 1) pool_item<4>(AP, Pb, MC, l, m, c0); else if (g == 2) pool_item<8>(AP, Pb, MC, l, m, c0); else pool_item<16>(AP, Pb, MC, l, m, c0); } }
            for (int it = tid; it < 32 * 96; it += NTHR) { const int m = r0 + it / 96, c0 = (it % 96) * 8;
                float z0[8], z1[8], z2[8], w0[8], w1[8], w2[8], bg[8], o[8];
                conv_z(AP, Pb, l, m, 0, c0, z0); conv_z(AP, Pb, l, m, 1, c0, z1); conv_z(AP, Pb, l, m, 2, c0, z2);
                ld8f(AP->conv_w + (size_t)(l * 3 + 0) * CW + c0, w0); ld8f(AP->conv_w + (size_t)(l * 3 + 1) * CW + c0, w1); ld8f(AP->conv_w + (size_t)(l * 3 + 2) * CW + c0, w2);
                unpack8(*(const v4u*)(Pb + (size_t)m * INW + O2 + c0), bg);
#pragma unroll
                for (int e = 0; e < 8; ++e) o[e] = bg[e] * (w0[e] * z0[e] + w1[e] * z1[e] + w2[e] * z2[e]);
                *(v4u*)(MC + (size_t)m * DM + O1 + c0) = pack8(o); }
        }
    }
    constexpr int S_PP = NBAT * PHIST * 64, S_PS = DBAT * PHIST * 64, S_CP = NBAT * 2 * 96, S_CS = DBAT * 2 * 96, S_ALL = S_PP + S_PS + S_CP + S_CS;
    for (int it = vb * NTHR + tid; it < S_ALL; it += G * NTHR) {
        int r = it; float f[8];
        if (r < S_PP) { const int cg = r % 64, i = (r / 64) % PHIST, b = r / (64 * PHIST); unpack8(*(const v4u*)(Pb + (size_t)(b * SEQ + SEQ - PHIST + i) * INW + cg * 8), f);
            st8f(AP->out + OUT_POOLP + ((size_t)(l * NBAT + b) * PHIST + i) * PW + cg * 8, f); continue; } r -= S_PP;
        if (r < S_PS) { const int cg = r % 64, i = (r / 64) % PHIST, si = r / (64 * PHIST);
            if (i < PHIST - DSEQ) ld8f(AP->state_pool + ((size_t)(l * DBAT + si) * PHIST + i + DSEQ) * PW + cg * 8, f); else unpack8(*(const v4u*)(Pb + (size_t)(MP + si * DSEQ + i - (PHIST - DSEQ)) * INW + cg * 8), f);
            st8f(AP->out + OUT_POOLS + ((size_t)(l * DBAT + si) * PHIST + i) * PW + cg * 8, f); continue; } r -= S_PS;
        if (r < S_CP) { const int cg = r % 96, i = (r / 96) % 2, b = r / 192; const int m = b * SEQ + SEQ - 2 + i; float a[8], c[8];
            unpack8(*(const v4u*)(Pb + (size_t)m * INW + O3 + cg * 8), a); unpack8(*(const v4u*)(Pb + (size_t)m * INW + O1 + cg * 8), c);
#pragma unroll
            for (int e = 0; e < 8; ++e) f[e] = a[e] * c[e];
            st8f(AP->out + OUT_CONVP + ((size_t)(l * NBAT + b) * 2 + i) * CW + cg * 8, f); continue; } r -= S_CP;
        { const int cg = r % 96, i = (r / 96) % 2, si = r / 192; const int m = MP + si * DSEQ + DSEQ - 2 + i; float a[8], c[8];
            unpack8(*(const v4u*)(Pb + (size_t)m * INW + O3 + cg * 8), a); unpack8(*(const v4u*)(Pb + (size_t)m * INW + O1 + cg * 8), c);
#pragma unroll
            for (int e = 0; e < 8; ++e) f[e] = a[e] * c[e];
            st8f(AP->out + OUT_CONVS + ((size_t)(l * DBAT + si) * 2 + i) * CW + cg * 8, f); }
    }
}

__device__ __forceinline__ void phase_postnorm(ArgsP AP, const float* gpost, bool first, bool want_next, int lane, int wave, int vb, int G) {
    unsigned char* ws = AP->ws; const float* MIX = (const float*)(ws + WS_MIX); const float* SSQ = (const float*)(ws + WS_SSQP);
    const int gw = vb * NWAVES + wave, NGW = G * NWAVES;
    for (int m = gw; m < MTOT; m += NGW) {
        float q = lane < 32 ? SSQ[(size_t)m * 32 + lane] : 0.f; q = wave_sum(q); const float ri = rsqrtf(q * (1.f / DM) + EPS);
        const float* xs = first ? (m < MP ? AP->x_prompt + (size_t)m * DM : AP->x_sample + (size_t)(m - MP) * DM) : AP->out + (size_t)m * DM;
        const f32x4* xr = (const f32x4*)xs + lane; const f32x4* yr = (const f32x4*)(MIX + (size_t)m * DM) + lane; const f32x4* gr = (const f32x4*)gpost + lane;
        f32x4* xo = (f32x4*)(AP->out + (size_t)m * DM) + lane; unsigned long long* o8 = (unsigned long long*)((bf16*)(ws + WS_XB) + (size_t)m * DM) + lane; float s = 0.f;
#pragma unroll
        for (int j = 0; j < 8; ++j) { const f32x4 x = xr[64 * j], y = yr[64 * j], g = gr[64 * j]; const f32x4 v = x + y * ri * g; xo[64 * j] = v;
            if (want_next) { o8[64 * j] = (unsigned long long)pk2(v.x, v.y) | ((unsigned long long)pk2(v.z, v.w) << 32); s += (v.x * v.x + v.y * v.y) + (v.z * v.z + v.w * v.w); } }
        if (want_next) { s = wave_sum(s); if (lane == 0) ((float*)(ws + WS_RINV))[m] = rsqrtf(s * (1.f / DM) + EPS); }
    }
}

__device__ __forceinline__ void phase_convgelu(ArgsP AP, int l, int tid, int vb, int G) {
    unsigned char* ws = AP->ws; const bf16* AB = (const bf16*)(ws + WS_R1); bf16* H = (bf16*)(ws + WS_R2);
    constexpr int CG = FF / 8;
    for (int it = vb * NTHR + tid; it < MTOT * CG; it += G * NTHR) {
        const int m = it / CG, c0 = (it % CG) * 8; const bool samp = m >= MP; int t, si = 0, T; if (!samp) { t = m & (SEQ - 1); T = SEQ; } else { si = (m - MP) >> 3; t = (m - MP) & 7; T = DSEQ; }
        float g[3][8];
#pragma unroll
        for (int j = 0; j < 3; ++j) { const int tt = t - 2 + j; const bool ok = tt >= 0; const int row = ok ? m - 2 + j : m; float a[8]; unpack8(*(const v4u*)(AB + (size_t)row * FF2 + c0), a);
            if (samp) { float p[8]; int pr = 2 + tt; pr = pr < 0 ? 0 : (pr > 1 ? 1 : pr); ld8f(AP->state_ffn + ((size_t)(l * DBAT + si) * 2 + pr) * FF + c0, p);
#pragma unroll
                for (int e = 0; e < 8; ++e) g[j][e] = ok ? a[e] : p[e]; }
            else {
#pragma unroll
                for (int e = 0; e < 8; ++e) g[j][e] = ok ? a[e] : 0.f; } }
        float w0[8], w1[8], w2[8], cb[8], vv[8], o[8];
        ld8f(AP->ffn_conv_w + (size_t)(l * 3 + 0) * FF + c0, w0); ld8f(AP->ffn_conv_w + (size_t)(l * 3 + 1) * FF + c0, w1); ld8f(AP->ffn_conv_w + (size_t)(l * 3 + 2) * FF + c0, w2); ld8f(AP->ffn_conv_b + (size_t)l * FF + c0, cb);
        unpack8(*(const v4u*)(AB + (size_t)m * FF2 + FF + c0), vv);
#pragma unroll
        for (int e = 0; e < 8; ++e) { const float x = w0[e] * g[0][e] + w1[e] * g[1][e] + w2[e] * g[2][e] + cb[e]; const float y = 1.5957691216057308f * (x + 0.044715f * x * x * x);
            o[e] = x / (1.f + __expf(-y)) * vv[e]; }
        *(v4u*)(H + (size_t)m * FF + c0) = pack8(o);
        if (t >= T - 2) { float* dst = samp ? AP->out + OUT_FFNS + ((size_t)(l * DBAT + si) * 2 + (t - (T - 2))) * FF + c0 : AP->out + OUT_FFNP + ((size_t)(l * NBAT + (m >> 11)) * 2 + (t - (T - 2))) * FF + c0; st8f(dst, g[2]); }
    }
}

__global__ void __launch_bounds__(NTHR, 2) mk_fwd(Args kernarg_) {
    ArgsP AP = (ArgsP)__builtin_amdgcn_kernarg_segment_ptr();
    extern __shared__ __attribute__((aligned(16))) unsigned char lds_raw[];
    LAS unsigned char* lds = (LAS unsigned char*)lds_raw;
    volatile LAS unsigned* MISC = (volatile LAS unsigned*)(lds + MISC_OFF);
    const int tid0 = threadIdx.x;
    const int G = gridDim.x, bx = blockIdx.x, vb = (G % 8 == 0) ? (bx % 8) * (G / 8) + bx / 8 : bx;
    unsigned char* ws0 = AP->ws;
    for (int u = tid0; u < (LDS_BYTES - LDSCTL_OFF) / 4; u += NTHR) ((LAS unsigned*)(lds + LDSCTL_OFF))[u] = 0u;
    __syncthreads();
    XcdBarrier bar; bar.bar = (unsigned*)(ws0 + WS_CTL) + CW_BAR; bar.x = 0; bar.st = nullptr;
    if (!MK_PER_PHASE) bar = xcd_barrier_post((unsigned*)(ws0 + WS_CTL) + CW_BAR, MISC + 8);
    const int lo = AP->ph_lo, hi = AP->ph_hi;
#define IN(k) (lo <= (k) && (k) < hi)
#define OPAQUE_TID() int tid = tid0; asm volatile("" : "+v"(tid)); const int lane = tid & 63, wave = __builtin_amdgcn_readfirstlane(tid >> 6); unsigned char* ws = launder(AP)->ws; (void)lane; (void)wave; (void)ws
#define SEAM(k) do { if (!MK_PER_PHASE && IN(k) && IN((k) + 1)) xcd_barrier(bar); } while (0)
    if (IN(0)) { OPAQUE_TID(); p0_prologue(launder(AP), lds, tid, lane, wave, vb, G); } SEAM(0);
    for (int l = 0; l < DEPTH; ++l) {
        const int p = 1 + 8 * l;
        if (IN(p + 0)) { OPAQUE_TID(); pg8::Gemm g{(const bf16*)(ws + WS_XB), (const bf16*)(ws + WS_WIN + l * WIN_L), MTOT, INW, DM}; pg8::StaticOrder S; S.init(MTOT, INW, G, bx);
            pg8::EpiRowScaleBf16 E{(bf16*)(ws + WS_R1), INW, (const float*)(ws + WS_RINV)}; pg8::gemm_phase<pg8::EpiRowScaleBf16, pg8::StaticOrder, true, true>(lds + RING_OFF, g, S, E, tid); } SEAM(p + 0);
        if (IN(p + 1)) { OPAQUE_TID(); phase_mixers(launder(AP), l, lds, tid, lane, wave, vb, G); } SEAM(p + 1);
        if (IN(p + 2)) { OPAQUE_TID(); pg8::Gemm g{(const bf16*)(ws + WS_R2), (const bf16*)(ws + WS_WOUT + l * WOUT_L), MTOT, DM, DM}; pg8::StaticOrder S; S.init(MTOT, DM, G, bx);
            pg8::EpiF32Ssq E{(float*)(ws + WS_MIX), DM, (float*)(ws + WS_SSQP)}; pg8::gemm_phase<pg8::EpiF32Ssq, pg8::StaticOrder, true, true>(lds + RING_OFF, g, S, E, tid); } SEAM(p + 2);
        if (IN(p + 3)) { OPAQUE_TID(); phase_postnorm(launder(AP), AP->g_mix_post + l * DM, l == 0, true, lane, wave, vb, G); } SEAM(p + 3);
        if (IN(p + 4)) { OPAQUE_TID(); pg8::Gemm g{(const bf16*)(ws + WS_XB), (const bf16*)(ws + WS_WUP + l * WUP_L), MTOT, FF2, DM}; pg8::StaticOrder S; S.init(MTOT, FF2, G, bx);
            pg8::EpiRowScaleBf16 E{(bf16*)(ws + WS_R1), FF2, (const float*)(ws + WS_RINV)}; pg8::gemm_phase<pg8::EpiRowScaleBf16, pg8::StaticOrder, true, true>(lds + RING_OFF, g, S, E, tid); } SEAM(p + 4);
        if (IN(p + 5)) { OPAQUE_TID(); phase_convgelu(launder(AP), l, tid, vb, G); } SEAM(p + 5);
        if (IN(p + 6)) { OPAQUE_TID(); pg8::Gemm g{(const bf16*)(ws + WS_R2), (const bf16*)(ws + WS_WDN + l * WDN_L), MTOT, DM, FF}; pg8::StaticOrder S; S.init(MTOT, DM, G, bx);
            pg8::EpiF32Ssq E{(float*)(ws + WS_MIX), DM, (float*)(ws + WS_SSQP)}; pg8::gemm_phase<pg8::EpiF32Ssq, pg8::StaticOrder, true, true>(lds + RING_OFF, g, S, E, tid); } SEAM(p + 6);
        if (IN(p + 7)) { OPAQUE_TID(); phase_postnorm(launder(AP), AP->g_ffn_post + l * DM, false, l + 1 < DEPTH, lane, wave, vb, G); } SEAM(p + 7);
    }
#undef IN
#undef SEAM
}

extern "C" void kernel_launch(void* const* d_in, const int* in_sizes, int n_in, void* d_out, int out_size, void* d_ws, size_t ws_size, hipStream_t stream) {
    static int grid = 0;
    if (grid == 0) {
        if (n_in != 21 || out_size != (int)OUT_END || ws_size < WS_END) { fprintf(stderr, "kernel_launch: unexpected sizes n_in %d out %d ws %zu (need %zu)\n", n_in, out_size, ws_size, (size_t)WS_END); grid = -1; return; }
        int dev = 0, cus = 0, per_cu = 0;
        if (hipGetDevice(&dev) != hipSuccess || hipDeviceGetAttribute(&cus, hipDeviceAttributeMultiprocessorCount, dev) != hipSuccess) { grid = -1; return; }
        if (hipFuncSetAttribute((const void*)mk_fwd, hipFuncAttributeMaxDynamicSharedMemorySize, LDS_BYTES) != hipSuccess) { fprintf(stderr, "kernel_launch: hipFuncSetAttribute failed\n"); grid = -1; return; }
        if (hipOccupancyMaxActiveBlocksPerMultiprocessor(&per_cu, (const void*)mk_fwd, NTHR, LDS_BYTES) != hipSuccess || per_cu < 1) { fprintf(stderr, "kernel_launch: occupancy query says %d blocks per CU\n", per_cu); (void)hipGetLastError(); grid = -1; return; }
        grid = cus;
    }
    if (grid < 0) return;
    if (hipMemsetAsync((char*)d_ws + WS_CTL, 0, CTL_ZERO_BYTES, stream) != hipSuccess) { fprintf(stderr, "kernel_launch: memset failed\n"); return; }
    Args a{};
    const float** ap = (const float**)&a;
    for (int i = 0; i < 21; ++i) ap[i] = (const float*)d_in[i];
    a.out = (float*)d_out; a.ws = (unsigned char*)d_ws;
#if MK_PER_PHASE
    for (int p = 0; p < NPHASE; ++p) { a.ph_lo = p; a.ph_hi = p + 1; hipLaunchKernelGGL(mk_fwd, dim3(grid), dim3(NTHR), LDS_BYTES, stream, a); }
#else
    a.ph_lo = 0; a.ph_hi = NPHASE;
    void* kargs[] = {&a};
    hipError_t e = hipLaunchCooperativeKernel((const void*)mk_fwd, dim3(grid), dim3(NTHR), kargs, LDS_BYTES, stream);
    if (e != hipSuccess) fprintf(stderr, "kernel_launch: cooperative launch failed: %s (grid %d)\n", hipGetErrorString(e), grid);
#endif
}
```

```cpp
#include <hip/hip_runtime.h>
#include <cstdio>
#include <cstdint>
namespace pg8 {
#define PG8_LAS __attribute__((address_space(3)))
typedef unsigned short bf16_t;
typedef short bf16x8 __attribute__((ext_vector_type(8)));
typedef float f32x4 __attribute__((ext_vector_type(4)));
typedef unsigned u32x4 __attribute__((ext_vector_type(4)));
constexpr int BM = 256, BK = 64, HALF = 128, HTB = HALF * BK * 2  , STAGE_BYTES = 8 * HTB, NXCD = 8, WGM = 4;

__host__ __device__ __forceinline__ int lds_byte(int r, int c) { const int st = (r >> 4) * 2 + (c >> 5), rr = r & 15, cc = c & 31, ob = rr * 64 + cc * 2; return st * 1024 + (ob ^ (((ob >> 9) & 1) << 5)); }
__host__ __device__ __forceinline__ void stage_rc(int b, int& R, int& C) { const int st = b / 1024, sb = b % 1024, swz = sb ^ (((sb >> 9) & 1) << 5); R = (st >> 1) * 16 + swz / 64; C = (st & 1) * 32 + (swz % 64) / 2; }
__host__ __device__ __forceinline__ int perm32(int rho) { const int n = rho >> 4, i = rho & 15; return 8 * (i >> 2) + 4 * n + (i & 3); }

struct Unit { int pm, pn, kt0, nkt, slab; };
struct Gemm { const bf16_t* A; const bf16_t* Bt; int M, N, K; };

struct StaticOrder {
    int nM, nN, nwg, G, c, nkt, wgm;
    __host__ __device__ void init(int M, int N, int G_, int c_, int K, int wgm_ = WGM) { nM = M / BM; nN = N / BM; nwg = nM * nN; G = G_; c = c_; nkt = K / BK; wgm = wgm_; }
    __host__ __device__ bool next(int i, Unit& u) const {
        const long L = (long)i * G + c; if (L >= nwg) return false; u.kt0 = 0; u.nkt = nkt; u.slab = -1;
        int wgid = (int)L; { const int q = nwg / NXCD, r = nwg % NXCD, xcd = wgid % NXCD, off = wgid / NXCD; wgid = (xcd < r ? xcd * (q + 1) : r * (q + 1) + (xcd - r) * q) + off; }
        const int nig = wgm * nN, gid = wgid / nig, fm = gid * wgm, gsz = (nM - fm) < wgm ? (nM - fm) : wgm;
        u.pm = fm + ((wgid % nig) % gsz); u.pn = (wgid % nig) / gsz; return true;
    }
    __device__ __forceinline__ void a_ready(const Unit&) const {}
    __device__ __forceinline__ void done(const Unit&) const {}
};

struct SplitTailOrder : StaticOrder {
    int ns, ntail, nfull;
    __host__ __device__ void init(int M, int N, int G_, int c_, int K, int ns_, int wgm_ = WGM) { StaticOrder::init(M, N, G_, c_, K, wgm_); nfull = nwg / G; ntail = nwg - nfull * G; ns = ns_; if (ntail == 0 || ns * ntail > G || ns > nkt / 2) ns = 1; }
    __host__ __device__ bool next(int i, Unit& u) const {
        if (i < nfull || ns == 1) return StaticOrder::next(i, u);
        if (i > nfull) return false;
        const int ti = c % ntail, s = c / ntail; if (s >= ns) return false;
        StaticOrder t = *this; t.c = ti; if (!t.StaticOrder::next(nfull, u)) return false;
        const int h = nkt / 2, k0 = 2 * ((s * h) / ns), k1 = 2 * (((s + 1) * h) / ns); u.kt0 = k0; u.nkt = k1 - k0; u.slab = ti * ns + s; return true;
    }
    __host__ __device__ int tail_slot(int pm, int pn) const {
        if (ns == 1) return -1;
        const int gid = pm / wgm, fm = gid * wgm, gsz = (nM - fm) < wgm ? (nM - fm) : wgm; const int wgid = gid * wgm * nN + pn * gsz + (pm - fm);
        const int q = nwg / NXCD, r = nwg % NXCD; int xcd, off; if (wgid < r * (q + 1)) { xcd = wgid / (q + 1); off = wgid % (q + 1); } else { const int w2 = wgid - r * (q + 1); xcd = r + w2 / q; off = w2 % q; }
        const long L = (long)off * NXCD + xcd; if (L < (long)nfull * G) return -1; return (int)(L - (long)nfull * G) * ns;
    }
};

typedef float f32x2c __attribute__((ext_vector_type(2))); typedef __bf16 bf16x2c __attribute__((ext_vector_type(2)));
__device__ __forceinline__ unsigned cvt_pk_bf16(float lo, float hi) { const f32x2c v = {lo, hi}; return __builtin_bit_cast(unsigned, __builtin_convertvector(v, bf16x2c)); }
struct EpiRowScaleBf16 {
    static constexpr bool PERM = true, AFTER_DRAIN = false;
    bf16_t* O; int ldc; const float* rs; float* vpart; int pn0;
    __device__ __forceinline__ void operator()(const f32x4 (&acc)[2][2][4][2], const Unit& u, int wr, int wc, int fr, int fq) const {
        const int row0 = u.pm * BM + wr * 64 + fr, col0 = u.pn * BM + wc * 32 + 8 * fq; const bool want_ssq = u.pn >= pn0;
        float sv[2][4];
#pragma unroll
        for (int ai = 0; ai < 2; ++ai)
#pragma unroll
            for (int m = 0; m < 4; ++m) sv[ai][m] = rs[row0 + ai * HALF + m * 16];
#pragma unroll
        for (int ai = 0; ai < 2; ++ai)
#pragma unroll
            for (int m = 0; m < 4; ++m) { const int r = row0 + ai * HALF + m * 16; const float s = sv[ai][m]; bf16_t* rowp = O + (size_t)r * ldc + col0;
#pragma unroll
                for (int bj = 0; bj < 2; ++bj) { const f32x4 v0 = acc[ai][bj][m][0] * s, v1 = acc[ai][bj][m][1] * s;
                    u32x4 w; w.x = cvt_pk_bf16(v0[0], v0[1]); w.y = cvt_pk_bf16(v0[2], v0[3]); w.z = cvt_pk_bf16(v1[0], v1[1]); w.w = cvt_pk_bf16(v1[2], v1[3]);
                    *(u32x4*)(rowp + bj * HALF) = w; }
                if (want_ssq) { float q = 0.f;
#pragma unroll
                    for (int bj = 0; bj < 2; ++bj)
#pragma unroll
                        for (int n = 0; n < 2; ++n) { const f32x4 x = acc[ai][bj][m][n] * s; q += (x[0] * x[0] + x[1] * x[1]) + (x[2] * x[2] + x[3] * x[3]); }
                    q += __shfl_xor(q, 16); q += __shfl_xor(q, 32);
                    if (fq == 0) vpart[(size_t)r * 12 + (u.pn - pn0) * 4 + wc] = q; } }
    }
};
struct EpiMixTile {
    static constexpr bool PERM = true, AFTER_DRAIN = false;
    bf16_t* O; int ldc; float* part;
    __device__ __forceinline__ void operator()(const f32x4 (&acc)[2][2][4][2], const Unit& u, int wr, int wc, int fr, int fq) const {
        const bool sl = u.slab >= 0; const size_t ld = sl ? (size_t)BM : (size_t)ldc;
        { bf16_t* base = sl ? (bf16_t*)part + (size_t)u.slab * (BM * BM) + (size_t)(wr * 64 + fr) * BM + wc * 32 + 8 * fq : O + (size_t)(u.pm * BM + wr * 64 + fr) * ldc + u.pn * BM + wc * 32 + 8 * fq;
#pragma unroll
            for (int ai = 0; ai < 2; ++ai)
#pragma unroll
                for (int m = 0; m < 4; ++m) { bf16_t* rowp = base + (size_t)(ai * HALF + m * 16) * ld;
#pragma unroll
                    for (int bj = 0; bj < 2; ++bj) { const f32x4 v0 = acc[ai][bj][m][0], v1 = acc[ai][bj][m][1];
                        u32x4 w; w.x = cvt_pk_bf16(v0[0], v0[1]); w.y = cvt_pk_bf16(v0[2], v0[3]); w.z = cvt_pk_bf16(v1[0], v1[1]); w.w = cvt_pk_bf16(v1[2], v1[3]);
                        *(u32x4*)(rowp + bj * HALF) = w; } }
        }
    }
};

template <class Epi, class Sched, bool ALIGN_EPI = false, bool SP2 = false>
__device__ __forceinline__ void gemm_phase(PG8_LAS unsigned char* lds, const Gemm g, const Sched& S, const Epi& E, const int tid_in  ) {
    const int tid = tid_in, wid = __builtin_amdgcn_readfirstlane(tid >> 6), lane = tid & 63, wr = wid >> 2, wc = wid & 3, fr = lane & 15, fq = lane >> 4;
    const int K = g.K;
    unsigned voffA[2], voffB[2];
#pragma unroll
    for (int i = 0; i < 2; ++i) { int R, C; stage_rc(tid * 16 + i * 8192, R, C); const int Rb = Epi::PERM ? ((R & ~31) + perm32(R & 31)) : R;
        voffA[i] = (unsigned)(R * K + C) * 2u; voffB[i] = (unsigned)(Rb * K + C) * 2u; }
    const size_t kstep = (size_t)(BK * 2);
    const size_t hstep = (size_t)HALF * K * 2;
    const size_t tstep = 2 * hstep;
    const unsigned ldsw = (unsigned)wid * 1024u;
    const int aoff = lds_byte(wr * 64 + fr, fq * 8), boff = lds_byte(wc * 32 + fr, fq * 8);
#define PG8_SA(b, h) (((b) * 2 + (h)) * HTB)
#define PG8_SB(b, h) ((4 + (b) * 2 + (h)) * HTB)
#define PG8_STAGE(bufoff, gbase, voff) do { _Pragma("unroll") for (int _i = 0; _i < 2; ++_i) \
        __builtin_amdgcn_global_load_lds((const unsigned*)((const char*)(gbase) + (voff)[_i]), (PG8_LAS unsigned*)(lds + (bufoff) + ldsw + _i * 8192), 16, 0, 0); } while (0)
#define PG8_LDA(dst, b, h) do { _Pragma("unroll") for (int m = 0; m < 4; ++m) _Pragma("unroll") for (int k = 0; k < 2; ++k) dst[m][k] = *(const PG8_LAS bf16x8*)(lds + PG8_SA(b, h) + aoff + m * 2048 + k * 1024); } while (0)
#define PG8_LDB(dst, b, h) do { _Pragma("unroll") for (int n = 0; n < 2; ++n) _Pragma("unroll") for (int k = 0; k < 2; ++k) dst[n][k] = *(const PG8_LAS bf16x8*)(lds + PG8_SB(b, h) + boff + n * 2048 + k * 1024); } while (0)
#define PG8_MMA(ai, bj, At, Bt) do { __builtin_amdgcn_s_setprio(1); _Pragma("unroll") for (int m = 0; m < 4; ++m) _Pragma("unroll") for (int n = 0; n < 2; ++n) _Pragma("unroll") for (int k = 0; k < 2; ++k) \
        acc[ai][bj][m][n] = __builtin_amdgcn_mfma_f32_16x16x32_bf16(Bt[n][k], At[m][k], acc[ai][bj][m][n], 0, 0, 0); __builtin_amdgcn_s_setprio(0); } while (0)
#define PG8_WAIT_V(n) asm volatile("s_waitcnt vmcnt(" #n ")" ::: "memory")
#define PG8_WAIT_L(n) asm volatile("s_waitcnt lgkmcnt(" #n ")" ::: "memory")
#define PG8_BAR __builtin_amdgcn_s_barrier()
#define PG8_SCHED __builtin_amdgcn_sched_barrier(0)
    Unit cur, nxt; int ui = 0;
    if (!S.next(0, cur)) return;
    f32x4 acc[2][2][4][2];
#pragma unroll
    for (int a = 0; a < 2; ++a)
#pragma unroll
        for (int b = 0; b < 2; ++b)
#pragma unroll
            for (int m = 0; m < 4; ++m)
#pragma unroll
                for (int n = 0; n < 2; ++n) acc[a][b][m][n] = (f32x4){0.f, 0.f, 0.f, 0.f};
    bf16x8 At[4][2], B0[2][2], B1[2][2];
    const char* cA = (const char*)g.A + (size_t)cur.pm * tstep + (size_t)cur.kt0 * kstep; const char* cB = (const char*)g.Bt + (size_t)cur.pn * tstep + (size_t)cur.kt0 * kstep;
    S.a_ready(cur);
    if constexpr (SP2) {
        PG8_STAGE(PG8_SB(0, 0), cB, voffB); PG8_STAGE(PG8_SB(0, 1), cB + hstep, voffB); PG8_STAGE(PG8_SA(0, 0), cA, voffA); PG8_STAGE(PG8_SA(0, 1), cA + hstep, voffA);
        if (wr == 1) PG8_BAR;
        PG8_WAIT_V(2); PG8_BAR;
        PG8_STAGE(PG8_SB(1, 0), cB + kstep, voffB); PG8_STAGE(PG8_SA(1, 0), cA + kstep, voffA); PG8_STAGE(PG8_SB(1, 1), cB + hstep + kstep, voffB);
        PG8_WAIT_V(6); PG8_BAR;
    } else {
        PG8_STAGE(PG8_SB(0, 0), cB, voffB); PG8_STAGE(PG8_SA(0, 0), cA, voffA); PG8_STAGE(PG8_SB(0, 1), cB + hstep, voffB); PG8_STAGE(PG8_SA(0, 1), cA + hstep, voffA);
        if (wr == 1) PG8_BAR;
        PG8_WAIT_V(4); PG8_BAR;
        PG8_STAGE(PG8_SB(1, 0), cB + kstep, voffB); PG8_STAGE(PG8_SA(1, 0), cA + kstep, voffA); PG8_STAGE(PG8_SB(1, 1), cB + hstep + kstep, voffB);
        PG8_WAIT_V(6); PG8_BAR;
    }
    for (;;) {
        const bool has_next = S.next(ui + 1, nxt);
        const char* nA = has_next ? (const char*)g.A + (size_t)nxt.pm * tstep + (size_t)nxt.kt0 * kstep : cA; const char* nB = has_next ? (const char*)g.Bt + (size_t)nxt.pn * tstep + (size_t)nxt.kt0 * kstep : cB;
        const int ntc = cur.nkt;
        for (int t = 0; t < ntc; t += 2) {
            const bool last = (t == ntc - 2);
            const char* a1 = cA + (size_t)(t + 1) * kstep;
            const char* a2 = last ? nA : cA + (size_t)(t + 2) * kstep; const char* b2 = last ? nB : cB + (size_t)(t + 2) * kstep;
            const char* a3 = a2 + kstep; const char* b3 = b2 + kstep;
            if (last && has_next) S.a_ready(nxt);
            if constexpr (SP2) {
            PG8_LDB(B0, 0, 0); PG8_LDB(B1, 0, 1); PG8_SCHED; PG8_LDA(At, 0, 0); PG8_STAGE(PG8_SA(1, 1), a1 + hstep, voffA);
            PG8_WAIT_V(8); PG8_WAIT_L(0); PG8_BAR; PG8_MMA(0, 0, At, B0); PG8_MMA(0, 1, At, B1); PG8_BAR; PG8_SCHED;
            PG8_LDA(At, 0, 1); PG8_STAGE(PG8_SB(0, 0), b2, voffB); PG8_STAGE(PG8_SB(0, 1), b2 + hstep, voffB); PG8_STAGE(PG8_SA(0, 0), a2, voffA);
            PG8_WAIT_V(8); PG8_WAIT_L(0); PG8_BAR; PG8_MMA(1, 0, At, B0); PG8_MMA(1, 1, At, B1); PG8_BAR; PG8_SCHED;
            PG8_LDB(B0, 1, 0); PG8_LDB(B1, 1, 1); PG8_SCHED; PG8_LDA(At, 1, 0); PG8_STAGE(PG8_SA(0, 1), a2 + hstep, voffA);
            PG8_WAIT_V(8); PG8_WAIT_L(0); PG8_BAR; PG8_MMA(0, 0, At, B0); PG8_MMA(0, 1, At, B1); PG8_BAR; PG8_SCHED;
            PG8_LDA(At, 1, 1); PG8_STAGE(PG8_SB(1, 0), b3, voffB); PG8_STAGE(PG8_SB(1, 1), b3 + hstep, voffB); PG8_STAGE(PG8_SA(1, 0), a3, voffA);
            PG8_WAIT_V(8); PG8_WAIT_L(0); PG8_BAR; PG8_MMA(1, 0, At, B0); PG8_MMA(1, 1, At, B1); PG8_BAR; PG8_SCHED;
            } else {
            PG8_LDB(B0, 0, 0); PG8_SCHED; PG8_LDA(At, 0, 0); PG8_STAGE(PG8_SA(1, 1), a1 + hstep, voffA);
            PG8_WAIT_L(8); PG8_BAR; PG8_WAIT_L(0); PG8_MMA(0, 0, At, B0); PG8_BAR; PG8_SCHED;
            PG8_LDB(B1, 0, 1); PG8_STAGE(PG8_SB(0, 0), b2, voffB);
            PG8_BAR; PG8_WAIT_L(0); PG8_MMA(0, 1, At, B1); PG8_BAR;
            PG8_LDA(At, 0, 1); PG8_STAGE(PG8_SA(0, 0), a2, voffA);
            PG8_BAR; PG8_WAIT_L(0); PG8_MMA(1, 0, At, B0); PG8_BAR; PG8_SCHED;
            PG8_STAGE(PG8_SB(0, 1), b2 + hstep, voffB);
            PG8_WAIT_V(6); PG8_BAR; PG8_MMA(1, 1, At, B1); PG8_BAR;
            PG8_LDB(B0, 1, 0); PG8_SCHED; PG8_LDA(At, 1, 0); PG8_STAGE(PG8_SA(0, 1), a2 + hstep, voffA);
            PG8_WAIT_L(8); PG8_BAR; PG8_WAIT_L(0); PG8_MMA(0, 0, At, B0); PG8_BAR; PG8_SCHED;
            PG8_LDB(B1, 1, 1); PG8_STAGE(PG8_SB(1, 0), b3, voffB);
            PG8_BAR; PG8_WAIT_L(0); PG8_MMA(0, 1, At, B1); PG8_BAR;
            PG8_LDA(At, 1, 1); PG8_STAGE(PG8_SA(1, 0), a3, voffA);
            PG8_BAR; PG8_WAIT_L(0); PG8_MMA(1, 0, At, B0); PG8_BAR; PG8_SCHED;
            PG8_STAGE(PG8_SB(1, 1), b3 + hstep, voffB);
            PG8_WAIT_V(6); PG8_BAR; PG8_MMA(1, 1, At, B1); PG8_BAR;
            }
        }
        if constexpr (ALIGN_EPI) { if (wr == 0) PG8_BAR; }
        if constexpr (!Epi::AFTER_DRAIN) { E(acc, cur, wr, wc, fr, fq); S.done(cur); }
        if (!has_next) break;
#pragma unroll
        for (int a = 0; a < 2; ++a)
#pragma unroll
            for (int b = 0; b < 2; ++b)
#pragma unroll
                for (int m = 0; m < 4; ++m)
#pragma unroll
                    for (int n = 0; n < 2; ++n) acc[a][b][m][n] = (f32x4){0.f, 0.f, 0.f, 0.f};
        cur = nxt; cA = nA; cB = nB; ++ui;
        if constexpr (ALIGN_EPI) { if (wr == 1) PG8_BAR; }
    }
    PG8_WAIT_V(0);
    if constexpr (!ALIGN_EPI) { if (wr == 0) PG8_BAR; }
    PG8_BAR;
    if constexpr (Epi::AFTER_DRAIN) { E.fused(acc, cur, wr, wc, fr, fq, lds, wid, lane); S.done(cur); }
#undef PG8_SA
#undef PG8_SB
#undef PG8_STAGE
#undef PG8_LDA
#undef PG8_LDB
#undef PG8_MMA
#undef PG8_WAIT_V
#undef PG8_WAIT_L
#undef PG8_BAR
#undef PG8_SCHED
}
}
#define GAS __attribute__((address_space(1)))
#define LAS __attribute__((address_space(3)))
typedef unsigned short bf16;
typedef unsigned v4u __attribute__((ext_vector_type(4)));
typedef float f32x4 __attribute__((ext_vector_type(4)));
typedef short bf16x8 __attribute__((ext_vector_type(8)));
typedef GAS unsigned gu32;
typedef GAS unsigned long long gu64;
#define RLX_AGENT __ATOMIC_RELAXED, __HIP_MEMORY_SCOPE_AGENT
#define LDS_WAIT() asm volatile("s_waitcnt lgkmcnt(0)" ::: "memory")
#define VM_WAIT() asm volatile("s_waitcnt vmcnt(0)" ::: "memory")
__device__ __forceinline__ unsigned long long rt() { return __builtin_amdgcn_s_memrealtime(); }
__device__ __forceinline__ unsigned pk2(float lo, float hi) { return pg8::cvt_pk_bf16(lo, hi); }
__device__ __forceinline__ unsigned f2bf(float f) { return pg8::cvt_pk_bf16(f, 0.f) & 0xffffu; }

#define XB_TMO      128
#define XB_XCNT(j)  (256  + 64 * (j))
#define XB_XSUB(j)  (1280 + 64 * (j))
#define XB_XGEN(j)  (2304 + 64 * (j))
#define XB_TOP      3328
#define XB_TOPGEN   3392
#define XCD_BAR_WORDS 3456
#define XB_SPIN_CAP (1u << 18)

__device__ __forceinline__ unsigned xb_ld(unsigned* p)              { return __hip_atomic_load(p, __ATOMIC_RELAXED, __HIP_MEMORY_SCOPE_AGENT); }
__device__ __forceinline__ unsigned xb_add(unsigned* p, unsigned v) { return __hip_atomic_fetch_add(p, v, __ATOMIC_RELAXED, __HIP_MEMORY_SCOPE_AGENT); }
__device__ __forceinline__ unsigned xb_xcc_id() { return (unsigned)__builtin_amdgcn_s_getreg((3 << 11) | 20) & 0xFu; }
#define XB_SPIN(cond, bar) do { unsigned _sp = 0; while (cond) { __builtin_amdgcn_s_sleep(1); \
    if ((++_sp & 255u) == 0u) { if (xb_ld(&(bar)[XB_TMO])) break; if (_sp > XB_SPIN_CAP) { atomicAdd(&(bar)[XB_TMO], 1u); break; } } } } while (0)

struct XcdBarrier {
    unsigned* bar; unsigned x;
    volatile LAS unsigned* st;
};

__device__ __forceinline__ XcdBarrier xcd_barrier_post(unsigned* bar, volatile LAS unsigned* st) {
    XcdBarrier b; b.bar = bar; b.x = xb_xcc_id(); b.st = st;
    if (threadIdx.x == 0) (void)xb_add(&bar[XB_XCNT(b.x)], 1u);
    return b;
}
__device__ __forceinline__ void xcd_barrier_complete(unsigned* bar, unsigned x, unsigned& nloc, unsigned& nx) {
    const unsigned G = gridDim.x * gridDim.y * gridDim.z;
    unsigned sum, cnt, mine, sp = 0u;
    for (;;) {
        sum = 0u; cnt = 0u; mine = 0u;
#pragma unroll
        for (unsigned j = 0; j < 16; ++j) { const unsigned c = xb_ld(&bar[XB_XCNT(j)]); sum += c; cnt += (c > 0u) ? 1u : 0u; mine = (j == x) ? c : mine; }
        if (sum == G) break;
        __builtin_amdgcn_s_sleep(1);
        if ((++sp & 255u) == 0u) { if (xb_ld(&bar[XB_TMO])) break; if (sp > XB_SPIN_CAP) { atomicAdd(&bar[XB_TMO], 1u); break; } }
    }
    nloc = mine > 0u ? mine : 1u; nx = cnt > 0u ? cnt : 1u;
}

__device__ __forceinline__ void xcd_barrier(const XcdBarrier& b) {
    asm volatile("s_waitcnt vmcnt(0)" ::: "memory");
    __syncthreads();
    if (threadIdx.x == 0) {
        unsigned* bar = b.bar;
        __builtin_amdgcn_s_waitcnt(0);
        unsigned nloc = b.st[0], nx = b.st[1];
        if (nloc == 0u) { xcd_barrier_complete(bar, b.x, nloc, nx); b.st[0] = nloc; b.st[1] = nx; }
        const unsigned old = xb_add(&bar[XB_XSUB(b.x)], 1u);
        const unsigned gen = old / nloc;
        if (old + 1u == (gen + 1u) * nloc) {
            __builtin_amdgcn_fence(__ATOMIC_RELEASE, "agent");
            asm volatile("s_waitcnt vmcnt(0)" ::: "memory");
            const unsigned og = xb_add(&bar[XB_TOP], 1u);
            const unsigned tg = og / nx;
            if (og + 1u == (tg + 1u) * nx) xb_add(&bar[XB_TOPGEN], 1u);
            else XB_SPIN(xb_ld(&bar[XB_TOPGEN]) == tg, bar);
            __builtin_amdgcn_fence(__ATOMIC_ACQUIRE, "agent");
            xb_add(&bar[XB_XGEN(b.x)], 1u);
            asm volatile("s_waitcnt vmcnt(0)" ::: "memory");
        } else {
            XB_SPIN(xb_ld(&bar[XB_XGEN(b.x)]) == gen, bar);
            __builtin_amdgcn_fence(__ATOMIC_ACQUIRE, "agent");
            asm volatile("s_waitcnt vmcnt(0)" ::: "memory");
        }
    }
    __syncthreads();
}

#ifndef DUP_PHASE
#define DUP_PHASE -1
#endif
#ifndef MK_COOP_LAUNCH
#define MK_COOP_LAUNCH 1
#endif
#ifndef MK_PER_PHASE
#define MK_PER_PHASE 0
#endif
constexpr int NWAVES = 8, NTHR = NWAVES * 64;
constexpr int DM = 2048, MP = 8192, MS = 1024, MTOT = MP + MS, SEQ = 2048, NBAT = 4, DBAT = 128, DSEQ = 8, DEPTH = 2;
constexpr int PW = 512, CW = 768, SW = 768, INW = 4352, FF = 5632, FF2 = 2 * FF, PHIST = 15;
constexpr int O1 = 512, O2 = 1280, O3 = 2048, O4 = 2816, O5 = 3584;
constexpr float EPS = 1e-6f;
#ifndef MIX_DUP
#define MIX_DUP 0
#endif
#ifndef G3_LAST_CUS
#define G3_LAST_CUS 0
#endif
#ifndef WGM_G1
#define WGM_G1 4
#endif
#ifndef WGM_G2
#define WGM_G2 4
#endif
#ifndef WGM_G3
#define WGM_G3 4
#endif
#ifndef WGM_G4
#define WGM_G4 4
#endif
constexpr int NPHASE = 1 + 8 * DEPTH, NSPLIT = 8;
constexpr size_t OUT_POOLP = (size_t)MTOT * DM, OUT_POOLS = OUT_POOLP + (size_t)DEPTH * NBAT * PHIST * PW, OUT_CONVP = OUT_POOLS + (size_t)DEPTH * DBAT * PHIST * PW,
                 OUT_CONVS = OUT_CONVP + (size_t)DEPTH * NBAT * 2 * CW, OUT_FFNP = OUT_CONVS + (size_t)DEPTH * DBAT * 2 * CW, OUT_FFNS = OUT_FFNP + (size_t)DEPTH * NBAT * 2 * FF,
                 OUT_VS = OUT_FFNS + (size_t)DEPTH * DBAT * 2 * FF, OUT_END = OUT_VS + (size_t)DEPTH * DBAT * DSEQ * SW;
static_assert(OUT_END == 25853952, "d_out map");
constexpr size_t MiB = 1u << 20;
constexpr size_t WS_CTL = 0, CTL_ZERO_BYTES = 64 * 1024;
constexpr size_t WS_WIN = 1 * MiB, WIN_L = 17 * MiB, WS_WOUT = 35 * MiB, WOUT_L = 8 * MiB, WS_WUP = 51 * MiB, WUP_L = 44 * MiB, WS_WDN = 139 * MiB, WDN_L = 22 * MiB;
constexpr size_t WS_SGUW = 183 * MiB, WS_RINV = 184 * MiB, WS_SSQP = 185 * MiB, WS_XB = 187 * MiB, WS_MIX = 223 * MiB, WS_R1 = 295 * MiB, WS_R2 = 493 * MiB, WS_HALO = 592 * MiB, WS_SHALO = 598 * MiB, WS_PART = 610 * MiB, WS_END = 674 * MiB;
constexpr size_t HALO_SZ = (size_t)32 * 2 * FF;
constexpr size_t SHALO_SZ = (size_t)DBAT * 2 * FF;
static_assert(3 * HALO_SZ * 4 <= 6 * MiB && 2 * SHALO_SZ * 4 <= 12 * MiB, "halo buffers");
static_assert((size_t)INW * DM * 2 == WIN_L && (size_t)DM * DM * 2 == WOUT_L && (size_t)FF2 * DM * 2 == WUP_L && (size_t)DM * FF * 2 == WDN_L, "weight copies");
static_assert((size_t)MTOT * DM * 2 == 36 * MiB && (size_t)MTOT * DM * 4 == 72 * MiB && (size_t)MTOT * FF2 * 2 == 198 * MiB && (size_t)MTOT * FF * 2 == 99 * MiB, "activation buffers");
constexpr size_t WS_VPART = WS_SSQP + 1536 * 1024;
static_assert((size_t)MTOT * 32 * 4 <= 1536 * 1024 && (size_t)MTOT * 12 * 4 <= 512 * 1024, "ssq partial buffers");
constexpr int CW_BAR = 4096, CW_CENS = 8192;
static_assert((CW_CENS + 16 * 64) * 4 <= (int)CTL_ZERO_BYTES && (CW_BAR + 3456) <= CW_CENS, "control words inside the zeroed region");
constexpr int RING_OFF = 0, RING_BYTES = 131072, LDSCTL_OFF = RING_BYTES, MISC_OFF = LDSCTL_OFF + 320, XCH_OFF = RING_BYTES + 1024  , LDS_BYTES = 147456;

struct Args {
    const float *x_prompt, *x_sample, *state_pool, *state_conv, *state_ffn, *g_mix_pre, *g_mix_post, *g_ffn_pre, *g_ffn_post, *w_in, *pool_w, *pool_scale, *conv_w, *sgu_norm, *sgu_w, *sgu_b, *w_out,
        *ffn_up, *ffn_conv_w, *ffn_conv_b, *ffn_down;
    float* out; unsigned char* ws; int ph_lo, ph_hi;
};

typedef const __attribute__((address_space(4))) Args* ArgsP;
__device__ __forceinline__ ArgsP launder(ArgsP p) { asm volatile("" : "+s"(p)); return p; }

__device__ __forceinline__ float wave_sum(float v) {
#pragma unroll
    for (int o = 1; o < 64; o <<= 1) v += __shfl_xor(v, o);
    return v;
}
__device__ __forceinline__ float bflo(unsigned w) { return __builtin_bit_cast(float, w << 16); }
__device__ __forceinline__ float bfhi(unsigned w) { return __builtin_bit_cast(float, w & 0xffff0000u); }
__device__ __forceinline__ float bf1(bf16 b) { return __builtin_bit_cast(float, ((unsigned)b) << 16); }
__device__ __forceinline__ void unpack8(const v4u r, float (&f)[8]) { f[0] = bflo(r.x); f[1] = bfhi(r.x); f[2] = bflo(r.y); f[3] = bfhi(r.y); f[4] = bflo(r.z); f[5] = bfhi(r.z); f[6] = bflo(r.w); f[7] = bfhi(r.w); }
__device__ __forceinline__ v4u pack8(const float (&f)[8]) { v4u o; o.x = pk2(f[0], f[1]); o.y = pk2(f[2], f[3]); o.z = pk2(f[4], f[5]); o.w = pk2(f[6], f[7]); return o; }
__device__ __forceinline__ void ld8f(const float* p, float (&f)[8]) { const f32x4 a = *(const f32x4*)p, b = *(const f32x4*)(p + 4); f[0] = a.x; f[1] = a.y; f[2] = a.z; f[3] = a.w; f[4] = b.x; f[5] = b.y; f[6] = b.z; f[7] = b.w; }
__device__ __forceinline__ void st8f(float* p, const float (&f)[8]) { *(f32x4*)p = (f32x4){f[0], f[1], f[2], f[3]}; *(f32x4*)(p + 4) = (f32x4){f[4], f[5], f[6], f[7]}; }

__device__ __forceinline__ void tr_load(const float* W, int ldw, int k0, int n0, int lane, float (&v)[64]) {
    const float* src = W + (size_t)k0 * ldw + n0 + lane;
#pragma unroll
    for (int i = 0; i < 64; ++i) v[i] = src[(size_t)i * ldw];
}
__device__ __forceinline__ void tr_finish(float (&v)[64], bool has_gain, float gl  , bf16* WT, int ldk, LAS unsigned char* scr, int k0, int n0, int lane) {
    if (has_gain) {
#pragma unroll
        for (int i = 0; i < 64; ++i) v[i] *= __builtin_bit_cast(float, __builtin_amdgcn_readlane(__builtin_bit_cast(int, gl), i)); }
#pragma unroll
    for (int c = 0; c < 8; ++c) { v4u o; o.x = pk2(v[8 * c], v[8 * c + 1]); o.y = pk2(v[8 * c + 2], v[8 * c + 3]); o.z = pk2(v[8 * c + 4], v[8 * c + 5]); o.w = pk2(v[8 * c + 6], v[8 * c + 7]);
        *(LAS v4u*)(scr + lane * 144 + c * 16) = o; }
    LDS_WAIT(); asm volatile("" ::: "memory");
#pragma unroll
    for (int p = 0; p < 8; ++p) { const int n = p * 8 + (lane >> 3), c = lane & 7; const v4u o = *(const LAS v4u*)(scr + n * 144 + c * 16);
        *(GAS v4u*)(WT + (size_t)(n0 + n) * ldk + k0 + 8 * c) = o; }
    LDS_WAIT(); asm volatile("" ::: "memory");
}
template <class DstRow> __device__ __forceinline__ void tr_range(const float* W, int ldw, const float* gain, bf16* WT, int ldk, LAS unsigned char* scr, int nb, int kofs, int lo, int hi, int widx, int nw, int lane, DstRow drow) {
    for (int r = lo + widx; r < hi; r += 2 * nw) { const int r2 = r + nw; const bool two = r2 < hi;
        float va[64], vb[64]; const int ka = kofs + 64 * (r / nb), na = 64 * (r % nb), kb = kofs + 64 * ((two ? r2 : r) / nb), nbk = 64 * ((two ? r2 : r) % nb);
        const float gla = gain ? gain[ka + lane] : 1.f, glb = gain ? gain[kb + lane] : 1.f;
        tr_load(W, ldw, ka, na, lane, va); if (two) tr_load(W, ldw, kb, nbk, lane, vb);
        tr_finish(va, gain != nullptr, gla, WT, ldk, scr, ka, drow(na), lane);
        if (two) tr_finish(vb, gain != nullptr, glb, WT, ldk, scr, kb, drow(nbk), lane); }
}
__device__ __forceinline__ void x_row_to_bf16(const float* xrow, bf16* orow, float* rinv, int lane) {
    const f32x4* xr = (const f32x4*)xrow + lane; f32x4 v[8]; float s = 0.f;
#pragma unroll
    for (int j = 0; j < 8; ++j) { v[j] = xr[64 * j]; s += (v[j].x * v[j].x + v[j].y * v[j].y) + (v[j].z * v[j].z + v[j].w * v[j].w); }
    s = wave_sum(s);
    unsigned long long* o8 = (unsigned long long*)orow + lane;
#pragma unroll
    for (int j = 0; j < 8; ++j) o8[64 * j] = (unsigned long long)pk2(v[j].x, v[j].y) | ((unsigned long long)pk2(v[j].z, v[j].w) << 32);
    if (lane == 0) *rinv = rsqrtf(s * (1.f / DM) + EPS);
}
enum ConvJob { J_IN = 0, J_OUT = 1, J_FOLD = 2, J_UP = 3, J_DN = 4 };
typedef float f32x16 __attribute__((ext_vector_type(16)));
__device__ __forceinline__ void conv_job(ArgsP AP, unsigned char* ws, LAS unsigned char* lds, int job, int l, int part, int nparts, int widx, int nw, int lane, int wave) {
    LAS unsigned char* scr = lds + RING_OFF + wave * 16384;
    auto same = [](int n) { return n; };
    if (job == J_IN) { constexpr int nb = INW / 64, n = (DM / 64) * nb;
        tr_range(AP->w_in + (size_t)l * DM * INW, INW, AP->g_mix_pre + l * DM, (bf16*)(ws + WS_WIN + l * WIN_L), DM, scr, nb, 0, (int)((long)n * part / nparts), (int)((long)n * (part + 1) / nparts), widx, nw, lane, same); }
    else if (job == J_OUT) { constexpr int nb = DM / 64, n = ((DM - PW) / 64) * nb;
        tr_range(AP->w_out + (size_t)l * DM * DM, DM, nullptr, (bf16*)(ws + WS_WOUT + l * WOUT_L), DM, scr, nb, PW, (int)((long)n * part / nparts), (int)((long)n * (part + 1) / nparts), widx, nw, lane, same); }
    else if (job == J_UP) { constexpr int nb = FF2 / 64, n = (DM / 64) * nb;
        auto inter = [](int n0) { const int n2 = n0 < FF ? n0 : n0 - FF; return 256 * (n2 / 128) + (n2 % 128) + (n0 < FF ? 0 : 128); };
        tr_range(AP->ffn_up + (size_t)l * DM * FF2, FF2, AP->g_ffn_pre + l * DM, (bf16*)(ws + WS_WUP + l * WUP_L), DM, scr, nb, 0, (int)((long)n * part / nparts), (int)((long)n * (part + 1) / nparts), widx, nw, lane, inter); }
    else if (job == J_DN) { constexpr int nb = DM / 64, n = (FF / 64) * nb;
        tr_range(AP->ffn_down + (size_t)l * FF * DM, DM, nullptr, (bf16*)(ws + WS_WDN + l * WDN_L), FF, scr, nb, 0, (int)((long)n * part / nparts), (int)((long)n * (part + 1) / nparts), widx, nw, lane, same); }
    else {
        const int ntile = 4 * 64 * 4, lo = (int)((long)ntile * part / nparts), hi = (int)((long)ntile * (part + 1) / nparts);
        for (int t = lo + widx; t < hi; t += nw) { const int g = t >> 8, nblk = (t >> 2) & 63, cblk = t & 3, n0 = nblk * 32, c0 = cblk * 32, li = lane & 31, lk = lane >> 5;
            const float* wo = AP->w_out + (size_t)l * DM * DM + (size_t)(g * 128 + lk) * DM + n0 + li; const float* pw = AP->pool_w + ((size_t)(l * 4 + g) * 128 + c0 + li) * 128 + lk; const float* sc = AP->pool_scale + l * PW + g * 128 + lk;
            float a[64], b[64];
#pragma unroll
            for (int s = 0; s < 64; ++s) { a[s] = wo[(size_t)(2 * s) * DM] * sc[2 * s]; b[s] = pw[2 * s]; }
            f32x16 acc;
#pragma unroll
            for (int r = 0; r < 16; ++r) acc[r] = 0.f;
#pragma unroll
            for (int s = 0; s < 64; ++s) acc = __builtin_amdgcn_mfma_f32_32x32x2f32(a[s], b[s], acc, 0, 0, 0);
            bf16* dst = (bf16*)(ws + WS_WOUT + l * WOUT_L) + (size_t)n0 * DM + g * 128 + c0 + li;
#pragma unroll
            for (int r = 0; r < 16; ++r) dst[(size_t)((r & 3) + 8 * (r >> 2) + 4 * lk) * DM] = (bf16)f2bf(acc[r]);
        }
    }
}
__device__ __forceinline__ int gemm_cus(int nwg, int G) { const int R = (nwg + G - 1) / G; int g = ((nwg + R - 1) / R + 7) & ~7; return g < G ? g : G; }
__device__ __forceinline__ void conv_helper(ArgsP AP, unsigned char* ws, LAS unsigned char* lds, int slot, int l, int hidx, int nh, int lane, int wave) {
    const int widx = hidx * NWAVES + wave, nw = nh * NWAVES;
    if (slot == 0) conv_job(AP, ws, lds, J_UP, l, 0, 1, widx, nw, lane, wave);
    else if (slot == 1) { conv_job(AP, ws, lds, J_UP, l, 3, 5, widx, nw, lane, wave); conv_job(AP, ws, lds, J_UP, l, 4, 5, widx, nw, lane, wave); conv_job(AP, ws, lds, J_DN, l, 0, 1, widx, nw, lane, wave); }
    else { conv_job(AP, ws, lds, J_DN, l, 0, 1, widx, nw, lane, wave); if (l + 1 < DEPTH) {
        conv_job(AP, ws, lds, J_IN, l + 1, 0, 1, widx, nw, lane, wave); conv_job(AP, ws, lds, J_OUT, l + 1, 0, 1, widx, nw, lane, wave); conv_job(AP, ws, lds, J_FOLD, l + 1, 0, 1, widx, nw, lane, wave); } }
}
__device__ __forceinline__ void x_row_finish(const f32x4 (&v)[8], bf16* orow, float* rinv, int lane) {
    float s = 0.f;
#pragma unroll
    for (int j = 0; j < 8; ++j) s += (v[j].x * v[j].x + v[j].y * v[j].y) + (v[j].z * v[j].z + v[j].w * v[j].w);
    s = wave_sum(s);
    unsigned long long* o8 = (unsigned long long*)orow + lane;
#pragma unroll
    for (int j = 0; j < 8; ++j) o8[64 * j] = (unsigned long long)pk2(v[j].x, v[j].y) | ((unsigned long long)pk2(v[j].z, v[j].w) << 32);
    if (lane == 0) *rinv = rsqrtf(s * (1.f / DM) + EPS);
}
__device__ __forceinline__ void p0_prologue(ArgsP AP, LAS unsigned char* lds, int tid, int lane, int wave, int vb, int G) {
    unsigned char* ws = AP->ws;
    const int gw = vb * NWAVES + wave, NGW = G * NWAVES;
    conv_job(AP, ws, lds, J_FOLD, 0, 0, 1, gw, NGW, lane, wave);
    conv_job(AP, ws, lds, J_IN, 0, 0, 1, gw, NGW, lane, wave);
    conv_job(AP, ws, lds, J_OUT, 0, 0, 1, gw, NGW, lane, wave);
    { bf16* sw = (bf16*)(ws + WS_SGUW);
      for (int i = vb * NTHR + tid; i < DEPTH * 6 * 128 * 128; i += G * NTHR) { const int q = (i >> 7) & 127, s = i & 127; sw[i] = (bf16)(s <= q ? f2bf(AP->sgu_w[i]) : 0u); } }
    for (int m = gw; m < MTOT; m += NGW) { const float* src = m < MP ? AP->x_prompt + (size_t)m * DM : AP->x_sample + (size_t)(m - MP) * DM;
        x_row_to_bf16(src, (bf16*)(ws + WS_XB) + (size_t)m * DM, (float*)(ws + WS_RINV) + m, lane); }
}

__device__ __forceinline__ float v_row_rinv(const bf16* Pb, int row, int lane) {
    const uint2* src = (const uint2*)(Pb + (size_t)row * INW + O5 + lane * 12); float q = 0.f;
#pragma unroll
    for (int i = 0; i < 3; ++i) { const uint2 a = src[i]; const float f0 = bflo(a.x), f1 = bfhi(a.x), f2 = bflo(a.y), f3 = bfhi(a.y); q += (f0 * f0 + f1 * f1) + (f2 * f2 + f3 * f3); }
    q = wave_sum(q);
    return rsqrtf(q * (1.f / SW) + EPS);
}
template <int WIN> __device__ __forceinline__ void pool_ld_p(const bf16* Pb, int m, int t, int c0, v4u (&raw)[WIN]) {
#pragma unroll
    for (int j = 0; j < WIN; ++j) raw[j] = *(const v4u*)(Pb + (size_t)(t - j >= 0 ? m - j : m) * INW + c0);
}
template <int WIN> __device__ __forceinline__ void pool_red_p(const v4u (&raw)[WIN], int t, float (&o)[8]) {
    float s[8], cur[8]; unpack8(raw[0], cur);
#pragma unroll
    for (int e = 0; e < 8; ++e) s[e] = cur[e];
#pragma unroll
    for (int j = 1; j < WIN; ++j) { float fv[8]; unpack8(raw[j], fv); const float k = t - j >= 0 ? 1.f : 0.f;
#pragma unroll
        for (int e = 0; e < 8; ++e) s[e] += k * fv[e]; }
    const float ic = 1.f / (float)(t + 1 < WIN ? t + 1 : WIN);
#pragma unroll
    for (int e = 0; e < 8; ++e) o[e] = s[e] * ic - cur[e];
}
template <int WIN> __device__ __forceinline__ void pool_samp(ArgsP AP, const bf16* Pb, bf16* MC, int l, int m, int c0) {
    constexpr int NP = WIN < 8 ? WIN : 8, NS = WIN - 1;
    const int si = (m - MP) >> 3, t = (m - MP) & 7; const float* prev = AP->state_pool + ((size_t)(l * DBAT + si) * PHIST) * PW + c0;
    v4u raw[NP]; f32x4 sa[NS], sb[NS];
#pragma unroll
    for (int j = 0; j < NP; ++j) raw[j] = *(const v4u*)(Pb + (size_t)(j <= t ? m - j : m) * INW + c0);
#pragma unroll
    for (int i = 0; i < NS; ++i) { int pr = PHIST + t - (i + 1); pr = pr < 0 ? 0 : (pr > PHIST - 1 ? PHIST - 1 : pr); sa[i] = *(const f32x4*)(prev + (size_t)pr * PW); sb[i] = *(const f32x4*)(prev + (size_t)pr * PW + 4); }
    float s[8], cur[8]; unpack8(raw[0], cur);
#pragma unroll
    for (int e = 0; e < 8; ++e) s[e] = cur[e];
#pragma unroll
    for (int j = 1; j < NP; ++j) { float fv[8]; unpack8(raw[j], fv); const float k = j <= t ? 1.f : 0.f;
#pragma unroll
        for (int e = 0; e < 8; ++e) s[e] += k * fv[e]; }
#pragma unroll
    for (int i = 0; i < NS; ++i) { const float k = (i + 1) > t ? 1.f : 0.f; s[0] += k * sa[i].x; s[1] += k * sa[i].y; s[2] += k * sa[i].z; s[3] += k * sa[i].w; s[4] += k * sb[i].x; s[5] += k * sb[i].y; s[6] += k * sb[i].z; s[7] += k * sb[i].w; }
    float o[8];
#pragma unroll
    for (int e = 0; e < 8; ++e) o[e] = s[e] * (1.f / (float)WIN) - cur[e];
    *(v4u*)(MC + (size_t)m * DM + c0) = pack8(o);
}
__device__ __forceinline__ void phase_mixers(ArgsP AP, int l, LAS unsigned char* lds, int tid, int lane, int wave, int vb, int G) {
    unsigned char* ws = AP->ws; const bf16* Pb = (const bf16*)(ws + WS_R1); bf16* MC = (bf16*)(ws + WS_R2); const bf16* SGW = (const bf16*)(ws + WS_SGUW); const float* VP = (const float*)(ws + WS_VPART);
    LAS float* rv = (LAS float*)lds; LAS bf16* vnT = (LAS bf16*)(lds + 512); constexpr int LDV = 136, LDG = 132; LAS float* GT = (LAS float*)(lds + 36864);
    constexpr int U_SP = (MP / 128) * 6, U_SS = DBAT, NU = U_SP + U_SS;
    for (int rp = 0; rp < (MIX_DUP == 1 ? 2 : 1); ++rp)
    for (int u = vb; u < NU; u += G) {
        if (u < U_SP) {
            const int cidx = u / 6, h = u % 6, r0 = cidx * 128;
            const int wq = wave >> 1, wd = wave & 1, fr = lane & 15, fq = lane >> 4;
            const bf16* Wg = SGW + (size_t)(l * 6 + h) * 128 * 128;
            v4u vraw[4], uraw[4]; bf16x8 af[4][2]; f32x4 vpa, vpb, vpc;
#pragma unroll
            for (int i = 0; i < 4; ++i) { const int vec = tid + NTHR * i; vraw[i] = *(const v4u*)(Pb + (size_t)(r0 + (vec & 127)) * INW + O5 + h * 128 + (vec >> 7) * 8);
                uraw[i] = *(const v4u*)(Pb + (size_t)(r0 + (vec >> 4)) * INW + O4 + h * 128 + (vec & 15) * 8); }
#pragma unroll
            for (int ks = 0; ks < 4; ++ks)
#pragma unroll
                for (int mi = 0; mi < 2; ++mi) af[ks][mi] = *(const bf16x8*)(Wg + (size_t)(32 * wq + 16 * mi + fr) * 128 + 32 * (ks <= wq ? ks : 0) + 8 * fq);
            { const f32x4* vp = (const f32x4*)(VP + (size_t)(r0 + (tid & 127)) * 12); vpa = vp[0]; vpb = vp[1]; vpc = vp[2]; }
            f32x4 nra[4], nrb[4]; float bqv[4];
#pragma unroll
            for (int i = 0; i < 4; ++i) { const int vec = tid + NTHR * i; const float* np = AP->sgu_norm + l * SW + h * 128 + (vec >> 7) * 8; nra[i] = *(const f32x4*)np; nrb[i] = *(const f32x4*)(np + 4); bqv[i] = AP->sgu_b[(l * 6 + h) * 128 + (vec >> 4)]; }
            if (tid < 128) rv[tid] = rsqrtf((((vpa.x + vpa.y) + (vpa.z + vpa.w)) + ((vpb.x + vpb.y) + (vpb.z + vpb.w)) + ((vpc.x + vpc.y) + (vpc.z + vpc.w))) * (1.f / SW) + EPS);
            __syncthreads();
#pragma unroll
            for (int i = 0; i < 4; ++i) { const int vec = tid + NTHR * i, s = vec & 127, d0 = (vec >> 7) * 8; float fv[8], nr[8];
                unpack8(vraw[i], fv); nr[0] = nra[i].x; nr[1] = nra[i].y; nr[2] = nra[i].z; nr[3] = nra[i].w; nr[4] = nrb[i].x; nr[5] = nrb[i].y; nr[6] = nrb[i].z; nr[7] = nrb[i].w; const float rs = rv[s];
#pragma unroll
                for (int e = 0; e < 8; ++e) vnT[(d0 + e) * LDV + s] = (bf16)f2bf(fv[e] * rs * nr[e]); }
            __syncthreads();
            f32x4 acc[2][4];
#pragma unroll
            for (int mi = 0; mi < 2; ++mi)
#pragma unroll
                for (int ni = 0; ni < 4; ++ni) acc[mi][ni] = (f32x4){0.f, 0.f, 0.f, 0.f};
#pragma unroll
            for (int ks = 0; ks < 4; ++ks) if (ks <= wq) {
                bf16x8 b[4];
#pragma unroll
                for (int ni = 0; ni < 4; ++ni) b[ni] = *(const LAS bf16x8*)(vnT + (64 * wd + 16 * ni + fr) * LDV + 32 * ks + 8 * fq);
#pragma unroll
                for (int mi = 0; mi < 2; ++mi)
#pragma unroll
                    for (int ni = 0; ni < 4; ++ni) acc[mi][ni] = __builtin_amdgcn_mfma_f32_16x16x32_bf16(af[ks][mi], b[ni], acc[mi][ni], 0, 0, 0);
            }
#pragma unroll
            for (int mi = 0; mi < 2; ++mi)
#pragma unroll
                for (int j = 0; j < 4; ++j)
#pragma unroll
                    for (int ni = 0; ni < 4; ++ni) GT[(32 * wq + 16 * mi + 4 * fq + j) * LDG + 64 * wd + 16 * ni + fr] = acc[mi][ni][j];
            __syncthreads();
#pragma unroll
            for (int i = 0; i < 4; ++i) { const int vec = tid + NTHR * i, q = vec >> 4, d0 = (vec & 15) * 8; float uu[8], o[8]; unpack8(uraw[i], uu);
                const f32x4 ga = *(const LAS f32x4*)(GT + q * LDG + d0), gb = *(const LAS f32x4*)(GT + q * LDG + d0 + 4); const float bq = bqv[i];
                o[0] = uu[0] * (ga.x + bq); o[1] = uu[1] * (ga.y + bq); o[2] = uu[2] * (ga.z + bq); o[3] = uu[3] * (ga.w + bq); o[4] = uu[4] * (gb.x + bq); o[5] = uu[5] * (gb.y + bq); o[6] = uu[6] * (gb.z + bq); o[7] = uu[7] * (gb.w + bq);
                *(v4u*)(MC + (size_t)(r0 + q) * DM + O2 + h * 128 + d0) = pack8(o); }
            __syncthreads();
        } else {
            const int si = u - U_SP, r0 = MP + 8 * si;
            if (tid < SW / 8) { const int c0 = tid * 8, h = c0 >> 7;
                v4u rvv[8], ruu[8]; f32x4 wq[8][2], na, nb, ba, bb; float rs8[8];
                { f32x4 vp[8][3];
#pragma unroll
                  for (int t = 0; t < 8; ++t) { const f32x4* p = (const f32x4*)(VP + (size_t)(r0 + t) * 12); vp[t][0] = p[0]; vp[t][1] = p[1]; vp[t][2] = p[2]; }
#pragma unroll
                  for (int t = 0; t < 8; ++t) { const f32x4 a = vp[t][0], b = vp[t][1], c = vp[t][2]; rs8[t] = rsqrtf((((a.x + a.y) + (a.z + a.w)) + ((b.x + b.y) + (b.z + b.w)) + ((c.x + c.y) + (c.z + c.w))) * (1.f / SW) + EPS); }
                  asm volatile("" : "+v"(rs8[0]), "+v"(rs8[1]), "+v"(rs8[2]), "+v"(rs8[3]), "+v"(rs8[4]), "+v"(rs8[5]), "+v"(rs8[6]), "+v"(rs8[7])); }
#pragma unroll
                for (int t = 0; t < 8; ++t) { rvv[t] = *(const v4u*)(Pb + (size_t)(r0 + t) * INW + O5 + c0); ruu[t] = *(const v4u*)(Pb + (size_t)(r0 + t) * INW + O4 + c0);
                    const float* wr = AP->sgu_w + ((size_t)(l * 6 + h) * 128 + t) * 128; wq[t][0] = *(const f32x4*)wr; wq[t][1] = *(const f32x4*)(wr + 4); }
                { const float* np = AP->sgu_norm + l * SW + c0; na = *(const f32x4*)np; nb = *(const f32x4*)(np + 4); const float* bp = AP->sgu_b + (l * 6 + h) * 128; ba = *(const f32x4*)bp; bb = *(const f32x4*)(bp + 4); }
                const float nr[8] = {na.x, na.y, na.z, na.w, nb.x, nb.y, nb.z, nb.w}, bq[8] = {ba.x, ba.y, ba.z, ba.w, bb.x, bb.y, bb.z, bb.w};
                float vn[8][8];
#pragma unroll
                for (int t = 0; t < 8; ++t) { const float rs = rs8[t]; float fv[8]; unpack8(rvv[t], fv);
#pragma unroll
                    for (int e = 0; e < 8; ++e) vn[t][e] = fv[e] * rs * nr[e];
                    st8f(AP->out + OUT_VS + ((size_t)(l * DBAT + si) * DSEQ + t) * SW + c0, vn[t]); }
#pragma unroll
                for (int q = 0; q < 8; ++q) { const float wv[8] = {wq[q][0].x, wq[q][0].y, wq[q][0].z, wq[q][0].w, wq[q][1].x, wq[q][1].y, wq[q][1].z, wq[q][1].w}; float uu[8], o[8]; unpack8(ruu[q], uu);
#pragma unroll
                    for (int e = 0; e < 8; ++e) { float gq = bq[q];
#pragma unroll
                        for (int t = 0; t < 8; ++t) if (t <= q) gq += wv[t] * vn[t][e];
                        o[e] = uu[e] * gq; }
                    *(v4u*)(MC + (size_t)(r0 + q) * DM + O2 + c0) = pack8(o); }
            }
        }
    }
    for (int rp = 0; rp < (MIX_DUP == 2 ? 2 : 1); ++rp)
    for (int it = vb * NTHR + tid; it < MP * 16; it += G * NTHR) { const int m = it >> 4, cg = it & 15, t = m & (SEQ - 1);
        v4u r0[2], r1[4], r2[8], r3[16]; float o0[8], o1[8], o2[8], o3[8];
        pool_ld_p<2>(Pb, m, t, cg * 8, r0); pool_ld_p<4>(Pb, m, t, (16 + cg) * 8, r1); pool_ld_p<8>(Pb, m, t, (32 + cg) * 8, r2); pool_ld_p<16>(Pb, m, t, (48 + cg) * 8, r3);
        pool_red_p<2>(r0, t, o0); pool_red_p<4>(r1, t, o1); pool_red_p<8>(r2, t, o2); pool_red_p<16>(r3, t, o3);
        bf16* dst = MC + (size_t)m * DM + cg * 8; *(v4u*)dst = pack8(o0); *(v4u*)(dst + 128) = pack8(o1); *(v4u*)(dst + 256) = pack8(o2); *(v4u*)(dst + 384) = pack8(o3); }
    for (int it = vb * NTHR + tid; it < 4 * MS * 16; it += G * NTHR) { const int g = it / (MS * 16), r = it % (MS * 16), m = MP + (r >> 4), c0 = (g * 16 + (r & 15)) * 8;
        if (g == 0) pool_samp<2>(AP, Pb, MC, l, m, c0); else if (g == 1) pool_samp<4>(AP, Pb, MC, l, m, c0); else if (g == 2) pool_samp<8>(AP, Pb, MC, l, m, c0); else pool_samp<16>(AP, Pb, MC, l, m, c0); }
    for (int rp = 0; rp < (MIX_DUP == 3 ? 2 : 1); ++rp)
    for (int it0 = vb * NTHR + tid; it0 < MP * 96; it0 += 2 * G * NTHR) {
        v4u rc[2][3], rh[2][3], rb[2]; f32x4 wa[2][3], wb[2][3]; int mm[2], cc[2], tt[2]; const bool two = it0 + G * NTHR < MP * 96;
#pragma unroll
        for (int h = 0; h < 2; ++h) { const int it = (h && two) ? it0 + G * NTHR : it0; mm[h] = it / 96; cc[h] = (it % 96) * 8; tt[h] = mm[h] & (SEQ - 1);
#pragma unroll
            for (int j = 0; j < 3; ++j) { const int row = tt[h] - 2 + j >= 0 ? mm[h] - 2 + j : mm[h]; rc[h][j] = *(const v4u*)(Pb + (size_t)row * INW + O3 + cc[h]); rh[h][j] = *(const v4u*)(Pb + (size_t)row * INW + O1 + cc[h]);
                wa[h][j] = *(const f32x4*)(AP->conv_w + (size_t)(l * 3 + j) * CW + cc[h]); wb[h][j] = *(const f32x4*)(AP->conv_w + (size_t)(l * 3 + j) * CW + cc[h] + 4); }
            rb[h] = *(const v4u*)(Pb + (size_t)mm[h] * INW + O2 + cc[h]); }
#pragma unroll
        for (int h = 0; h < 2; ++h) if (h == 0 || two) { float acc8[8], bg[8];
#pragma unroll
            for (int e = 0; e < 8; ++e) acc8[e] = 0.f;
#pragma unroll
            for (int j = 0; j < 3; ++j) { float a[8], b[8]; unpack8(rc[h][j], a); unpack8(rh[h][j], b); const float k = tt[h] - 2 + j >= 0 ? 1.f : 0.f; const float w[8] = {wa[h][j].x, wa[h][j].y, wa[h][j].z, wa[h][j].w, wb[h][j].x, wb[h][j].y, wb[h][j].z, wb[h][j].w};
#pragma unroll
                for (int e = 0; e < 8; ++e) acc8[e] += k * w[e] * (a[e] * b[e]); }
            unpack8(rb[h], bg); float o[8];
#pragma unroll
            for (int e = 0; e < 8; ++e) o[e] = bg[e] * acc8[e];
            *(v4u*)(MC + (size_t)mm[h] * DM + O1 + cc[h]) = pack8(o); }
    }
    for (int it = vb * NTHR + tid; it < MS * 96; it += G * NTHR) { const int m = MP + it / 96, c0 = (it % 96) * 8, si = (m - MP) >> 3, t = (m - MP) & 7;
        v4u rc[3], rh[3], rb; f32x4 wa[3], wb[3], sa[3], sb[3];
#pragma unroll
        for (int j = 0; j < 3; ++j) { const int tj = t - 2 + j, row = tj >= 0 ? m - 2 + j : m; int pr = 2 + tj; pr = pr < 0 ? 0 : (pr > 1 ? 1 : pr);
            rc[j] = *(const v4u*)(Pb + (size_t)row * INW + O3 + c0); rh[j] = *(const v4u*)(Pb + (size_t)row * INW + O1 + c0);
            const float* sp = AP->state_conv + ((size_t)(l * DBAT + si) * 2 + pr) * CW + c0; sa[j] = *(const f32x4*)sp; sb[j] = *(const f32x4*)(sp + 4);
            wa[j] = *(const f32x4*)(AP->conv_w + (size_t)(l * 3 + j) * CW + c0); wb[j] = *(const f32x4*)(AP->conv_w + (size_t)(l * 3 + j) * CW + c0 + 4); }
        rb = *(const v4u*)(Pb + (size_t)m * INW + O2 + c0);
        float acc8[8], bg[8], o[8];
#pragma unroll
        for (int e = 0; e < 8; ++e) acc8[e] = 0.f;
#pragma unroll
        for (int j = 0; j < 3; ++j) { float a[8], b[8]; unpack8(rc[j], a); unpack8(rh[j], b); const bool ok = t - 2 + j >= 0; const float w[8] = {wa[j].x, wa[j].y, wa[j].z, wa[j].w, wb[j].x, wb[j].y, wb[j].z, wb[j].w}, sv8[8] = {sa[j].x, sa[j].y, sa[j].z, sa[j].w, sb[j].x, sb[j].y, sb[j].z, sb[j].w};
#pragma unroll
            for (int e = 0; e < 8; ++e) acc8[e] += w[e] * (ok ? a[e] * b[e] : sv8[e]); }
        unpack8(rb, bg);
#pragma unroll
        for (int e = 0; e < 8; ++e) o[e] = bg[e] * acc8[e];
        *(v4u*)(MC + (size_t)m * DM + O1 + c0) = pack8(o); }
    constexpr int S_PP = NBAT * PHIST * 64, S_PS = DBAT * PHIST * 64, S_CP = NBAT * 2 * 96, S_CS = DBAT * 2 * 96, S_ALL = S_PP + S_PS + S_CP + S_CS;
    for (int rp = 0; rp < (MIX_DUP == 4 ? 2 : 1); ++rp)
    for (int it = vb * NTHR + tid; it < S_ALL; it += G * NTHR) {
        int r = it; float f[8];
        if (r < S_PP) { const int cg = r % 64, i = (r / 64) % PHIST, b = r / (64 * PHIST); unpack8(*(const v4u*)(Pb + (size_t)(b * SEQ + SEQ - PHIST + i) * INW + cg * 8), f);
            st8f(AP->out + OUT_POOLP + ((size_t)(l * NBAT + b) * PHIST + i) * PW + cg * 8, f); continue; } r -= S_PP;
        if (r < S_PS) { const int cg = r % 64, i = (r / 64) % PHIST, si = r / (64 * PHIST);
            if (i < PHIST - DSEQ) ld8f(AP->state_pool + ((size_t)(l * DBAT + si) * PHIST + i + DSEQ) * PW + cg * 8, f); else unpack8(*(const v4u*)(Pb + (size_t)(MP + si * DSEQ + i - (PHIST - DSEQ)) * INW + cg * 8), f);
            st8f(AP->out + OUT_POOLS + ((size_t)(l * DBAT + si) * PHIST + i) * PW + cg * 8, f); continue; } r -= S_PS;
        if (r < S_CP) { const int cg = r % 96, i = (r / 96) % 2, b = r / 192; const int m = b * SEQ + SEQ - 2 + i; float a[8], c[8];
            unpack8(*(const v4u*)(Pb + (size_t)m * INW + O3 + cg * 8), a); unpack8(*(const v4u*)(Pb + (size_t)m * INW + O1 + cg * 8), c);
#pragma unroll
            for (int e = 0; e < 8; ++e) f[e] = a[e] * c[e];
            st8f(AP->out + OUT_CONVP + ((size_t)(l * NBAT + b) * 2 + i) * CW + cg * 8, f); continue; } r -= S_CP;
        { const int cg = r % 96, i = (r / 96) % 2, si = r / 192; const int m = MP + si * DSEQ + DSEQ - 2 + i; float a[8], c[8];
            unpack8(*(const v4u*)(Pb + (size_t)m * INW + O3 + cg * 8), a); unpack8(*(const v4u*)(Pb + (size_t)m * INW + O1 + cg * 8), c);
#pragma unroll
            for (int e = 0; e < 8; ++e) f[e] = a[e] * c[e];
            st8f(AP->out + OUT_CONVS + ((size_t)(l * DBAT + si) * 2 + i) * CW + cg * 8, f); }
    }
}

__device__ __forceinline__ void phase_postnorm(ArgsP AP, const float* gpost, bool first, bool last, int K, int nsplit, int wgm, int lane, int wave, int vb, int G) {
    unsigned char* ws = AP->ws; const bf16* MIXB = (const bf16*)(ws + WS_MIX); const float* PART = (const float*)(ws + WS_PART); bf16* XB = (bf16*)(ws + WS_XB);
    pg8::SplitTailOrder S; S.init(MTOT, DM, G, 0, K, nsplit, wgm);
    const int gw = vb * NWAVES + wave, NGW = G * NWAVES, hi = lane >> 5, cl = (lane & 31) * 8;
    for (int m = gw; m < MTOT; m += NGW) {
        const int pm = m >> 8, rl = m & 255; float y[4][8]; float q = 0.f;
        const float* xs = m < MP ? AP->x_prompt + (size_t)m * DM : AP->x_sample + (size_t)(m - MP) * DM;
        v4u ry[4], rx[4]; f32x4 xa[4], xb[4], ga[4], gb[4];
#pragma unroll
        for (int jj = 0; jj < 4; ++jj) { const int c = 512 * jj + 8 * lane; ry[jj] = *(const v4u*)(MIXB + (size_t)m * DM + c); ga[jj] = *(const f32x4*)(gpost + c); gb[jj] = *(const f32x4*)(gpost + c + 4);
            if (first) { xa[jj] = *(const f32x4*)(xs + c); xb[jj] = *(const f32x4*)(xs + c + 4); } else rx[jj] = *(const v4u*)(XB + (size_t)m * DM + c); }
#pragma unroll
        for (int jj = 0; jj < 4; ++jj) { const int s0 = S.tail_slot(pm, 2 * jj), s1 = S.tail_slot(pm, 2 * jj + 1), slot = hi ? s1 : s0;
            unpack8(ry[jj], y[jj]);
            if (s0 >= 0 || s1 >= 0) { if (slot >= 0) { const bf16* pp = (const bf16*)PART + (size_t)slot * 65536 + (size_t)rl * 256 + cl; unpack8(*(const v4u*)pp, y[jj]);
                    for (int s = 1; s < S.ns; ++s) { float t[8]; unpack8(*(const v4u*)(pp + (size_t)s * 65536), t);
#pragma unroll
                        for (int e = 0; e < 8; ++e) y[jj][e] += t[e]; } } }
#pragma unroll
            for (int e = 0; e < 8; ++e) q += y[jj][e] * y[jj][e]; }
        q = wave_sum(q); const float ri = rsqrtf(q * (1.f / DM) + EPS); float s = 0.f;
#pragma unroll
        for (int jj = 0; jj < 4; ++jj) { const int c = 512 * jj + 8 * lane; float x[8], v[8]; const float g[8] = {ga[jj].x, ga[jj].y, ga[jj].z, ga[jj].w, gb[jj].x, gb[jj].y, gb[jj].z, gb[jj].w};
            if (first) { x[0] = xa[jj].x; x[1] = xa[jj].y; x[2] = xa[jj].z; x[3] = xa[jj].w; x[4] = xb[jj].x; x[5] = xb[jj].y; x[6] = xb[jj].z; x[7] = xb[jj].w; } else unpack8(rx[jj], x);
#pragma unroll
            for (int e = 0; e < 8; ++e) { v[e] = x[e] + y[jj][e] * ri * g[e]; s += v[e] * v[e]; }
            if (last) st8f(AP->out + (size_t)m * DM + c, v); else *(v4u*)(XB + (size_t)m * DM + c) = pack8(v); }
        if (!last) { s = wave_sum(s); if (lane == 0) ((float*)(ws + WS_RINV))[m] = rsqrtf(s * (1.f / DM) + EPS); }
    }
}

template <int CTRL> __device__ __forceinline__ float dpp_mov(float x) { return __builtin_bit_cast(float, __builtin_amdgcn_mov_dpp(__builtin_bit_cast(int, x), CTRL, 0xf, 0xf, false)); }
template <int CTRL> __device__ __forceinline__ float dpp_upd(float old, float x) { return __builtin_bit_cast(float, __builtin_amdgcn_update_dpp(__builtin_bit_cast(int, old), __builtin_bit_cast(int, x), CTRL, 0xf, 0xf, false)); }
typedef float f32x2 __attribute__((ext_vector_type(2)));
__device__ __forceinline__ f32x2 gelu_mul2(f32x2 x, f32x2 v) {
    const f32x2 p = (x * x) * (-0.10294324f) + (-2.3022082f), y = p * x; f32x2 e; e.x = __builtin_amdgcn_exp2f(y.x); e.y = __builtin_amdgcn_exp2f(y.y);
    const f32x2 d = e + 1.0f; f32x2 r; r.x = __builtin_amdgcn_rcpf(d.x); r.y = __builtin_amdgcn_rcpf(d.y); return (x * v) * r;
}
__device__ __forceinline__ float gelu_tanh(float x) { const f32x2 r = gelu_mul2((f32x2){x, x}, (f32x2){1.f, 1.f}); return r.x; }
struct EpiGateConvGelu {
    static constexpr bool PERM = true, AFTER_DRAIN = false;
    ArgsP ap; unsigned char* ws; int l; LAS float* xch;
    template <bool SAMP> __device__ __forceinline__ void body(const pg8::f32x4 (&acc)[2][2][4][2], const pg8::Unit& u, int wr, int wc, int fr_in, int fq_in) const {
        using pg8::f32x4;
        int fr = fr_in, fq = fq_in; asm volatile("" : "+v"(fr), "+v"(fq));
        const int cfl = wc * 32 + 8 * fq, cf = u.pn * 128 + cfl, row0 = u.pm * 256 + wr * 64 + fr;
        const float* rs = (const float*)(ws + WS_RINV);
        bf16* H = (bf16*)(ws + WS_R2); float* halo = (float*)(ws + WS_HALO); float* shalo = (float*)(ws + WS_SHALO);
        float sv[2][4];
#pragma unroll
        for (int ai = 0; ai < 2; ++ai)
#pragma unroll
            for (int m = 0; m < 4; ++m) sv[ai][m] = rs[row0 + ai * 128 + m * 16];
        LAS float* wl = xch + 1024;
        { const int t = (wr * 4 + wc) * 64 + fq * 16 + fr; if (t < 128) { const float* cwt = ap->ffn_conv_w + (size_t)l * 3 * FF + u.pn * 128 + t;
              wl[t] = cwt[0]; wl[128 + t] = cwt[FF]; wl[256 + t] = cwt[2 * FF]; wl[384 + t] = ap->ffn_conv_b[(size_t)l * FF + u.pn * 128 + t]; } }
        if (fr >= 14) {
#pragma unroll
            for (int ai = 0; ai < 2; ++ai)
#pragma unroll
                for (int n = 0; n < 2; ++n) *(LAS f32x4*)(xch + (((ai * 2 + wr) * 2 + (fr - 14)) * 128 + cfl + 4 * n)) = acc[ai][0][3][n] * sv[ai][3]; }
        asm volatile("s_waitcnt lgkmcnt(0)" ::: "memory"); __builtin_amdgcn_s_barrier(); asm volatile("" ::: "memory");
#pragma unroll
        for (int ai = 0; ai < 2; ++ai) {
            const int s = ai * 2 + wr;
            f32x4 gm1[2];
#pragma unroll
            for (int n = 0; n < 2; ++n) { gm1[n] = (f32x4){0.f, 0.f, 0.f, 0.f}; if (s > 0) gm1[n] = *(const LAS f32x4*)(xch + (((s - 1) * 2 + (fr >= 14 ? fr - 14 : 0)) * 128 + cfl + 4 * n)); }
#pragma unroll
            for (int m = 0; m < 4; ++m) {
                const int grow = row0 + ai * 128 + m * 16; const float sc = sv[ai][m];
                unsigned hw[4]; int wo = cfl; asm volatile("" : "+v"(wo));
#pragma unroll
                for (int n = 0; n < 2; ++n) {
                    const f32x4 g0 = acc[ai][0][m][n] * sc, vv = acc[ai][1][m][n] * sc; f32x4 g1, g2;
#pragma unroll
                    for (int j = 0; j < 4; ++j) { const float pj = gm1[n][j], cj = g0[j]; const float t1 = dpp_mov<0x121>(pj), t2 = dpp_mov<0x122>(pj); g1[j] = dpp_upd<0x111>(t1, cj); g2[j] = dpp_upd<0x112>(t2, cj); }
                    if (SAMP) {
                        const int t = fr & 7, si = (grow - MP) >> 3;
                        if (t < 2) { float* o = shalo + ((size_t)si * 2 + t) * FF + cf + 4 * n; *(f32x4*)o = g0; *(f32x4*)(o + SHALO_SZ) = vv; }
                        if (t >= 6) *(f32x4*)(ap->out + OUT_FFNS + ((size_t)(l * DBAT + si) * 2 + (t - 6)) * FF + cf + 4 * n) = g0;
                    } else {
                        if (s == 0 && m == 0 && fr < 2) { float* o = halo + HALO_SZ + ((size_t)u.pm * 2 + fr) * FF + cf + 4 * n; *(f32x4*)o = g0; *(f32x4*)(o + HALO_SZ) = vv; }
                        if (s == 3 && m == 3 && fr >= 14) {
                            *(f32x4*)(halo + ((size_t)u.pm * 2 + (fr - 14)) * FF + cf + 4 * n) = g0;
                            if ((u.pm & 7) == 7) *(f32x4*)(ap->out + OUT_FFNP + ((size_t)(l * NBAT + (u.pm >> 3)) * 2 + (fr - 14)) * FF + cf + 4 * n) = g0; }
                    }
#pragma unroll
                    for (int jj = 0; jj < 2; ++jj) { const int j = 2 * jj;
                        const f32x2 a2 = {g2[j], g2[j + 1]}, a1 = {g1[j], g1[j + 1]}, a0 = {g0[j], g0[j + 1]}, av = {vv[j], vv[j + 1]};
                        const f32x2 k0 = *(const LAS f32x2*)(wl + wo + 4 * n + j), k1 = *(const LAS f32x2*)(wl + 128 + wo + 4 * n + j), k2 = *(const LAS f32x2*)(wl + 256 + wo + 4 * n + j), kb = *(const LAS f32x2*)(wl + 384 + wo + 4 * n + j);
                        const f32x2 x = k0 * a2 + (k1 * a1 + (k2 * a0 + kb)); const f32x2 hv = gelu_mul2(x, av); hw[2 * n + jj] = pg8::cvt_pk_bf16(hv.x, hv.y); }
                    gm1[n] = g0;
                }
                *(v4u*)(H + (size_t)grow * FF + cf) = (v4u){hw[0], hw[1], hw[2], hw[3]};
            }
        }
    }
    __device__ __forceinline__ void operator()(const pg8::f32x4 (&acc)[2][2][4][2], const pg8::Unit& u, int wr, int wc, int fr, int fq) const {
        if (u.pm >= MP / 256) body<true>(acc, u, wr, wc, fr, fq); else body<false>(acc, u, wr, wc, fr, fq);
    }
};
__device__ __forceinline__ void phase_halofix(ArgsP AP, int l, int tid, int vb, int G) {
    unsigned char* ws = AP->ws; bf16* H = (bf16*)(ws + WS_R2); const float* BOTG = (const float*)(ws + WS_HALO); const float* TOPG = BOTG + HALO_SZ; const float* TOPV = BOTG + 2 * HALO_SZ;
    const float* SG = (const float*)(ws + WS_SHALO); const float* SV = SG + SHALO_SZ;
    constexpr int CG = FF / 8, NP = 28 * 2 * CG, NS = DBAT * 2 * CG;
    for (int it = vb * NTHR + tid; it < NP + NS; it += G * NTHR) {
        float o[8]; int c0, grow; const float *p2, *p1, *p0, *pv;
        if (it < NP) {
            c0 = (it % CG) * 8; const int r = (it / CG) & 1, pi = it / (2 * CG), pm = (pi / 7) * 8 + (pi % 7) + 1;
            if (r == 0) { p2 = BOTG + ((size_t)(pm - 1) * 2 + 0) * FF; p1 = BOTG + ((size_t)(pm - 1) * 2 + 1) * FF; p0 = TOPG + ((size_t)pm * 2 + 0) * FF; }
            else { p2 = BOTG + ((size_t)(pm - 1) * 2 + 1) * FF; p1 = TOPG + ((size_t)pm * 2 + 0) * FF; p0 = TOPG + ((size_t)pm * 2 + 1) * FF; }
            pv = TOPV + ((size_t)pm * 2 + r) * FF; grow = pm * 256 + r;
        } else {
            const int i2 = it - NP; c0 = (i2 % CG) * 8; const int t = (i2 / CG) & 1, si = i2 / (2 * CG); const float* st = AP->state_ffn + ((size_t)(l * DBAT + si) * 2) * FF;
            if (t == 0) { p2 = st; p1 = st + FF; } else { p2 = st + FF; p1 = SG + ((size_t)si * 2) * FF; }
            p0 = SG + ((size_t)si * 2 + t) * FF; pv = SV + ((size_t)si * 2 + t) * FF; grow = MP + si * DSEQ + t;
        }
        const float* cw = AP->ffn_conv_w + (size_t)l * 3 * FF + c0; const float* cbp = AP->ffn_conv_b + (size_t)l * FF + c0;
        f32x4 L[8][2];
#pragma unroll
        for (int h = 0; h < 2; ++h) { L[0][h] = *(const f32x4*)(p2 + c0 + 4 * h); L[1][h] = *(const f32x4*)(p1 + c0 + 4 * h); L[2][h] = *(const f32x4*)(p0 + c0 + 4 * h); L[3][h] = *(const f32x4*)(pv + c0 + 4 * h);
            L[4][h] = *(const f32x4*)(cw + 4 * h); L[5][h] = *(const f32x4*)(cw + FF + 4 * h); L[6][h] = *(const f32x4*)(cw + 2 * FF + 4 * h); L[7][h] = *(const f32x4*)(cbp + 4 * h); }
#pragma unroll
        for (int h = 0; h < 2; ++h)
#pragma unroll
            for (int e = 0; e < 4; ++e) o[4 * h + e] = gelu_tanh(L[4][h][e] * L[0][h][e] + L[5][h][e] * L[1][h][e] + L[6][h][e] * L[2][h][e] + L[7][h][e]) * L[3][h][e];
        *(v4u*)(H + (size_t)grow * FF + c0) = pack8(o);
    }
}

struct EpiNull {
    static constexpr bool PERM = true, AFTER_DRAIN = false;
    __device__ __forceinline__ void operator()(const pg8::f32x4 (&acc)[2][2][4][2], const pg8::Unit&, int, int, int, int) const {
#pragma unroll
        for (int a = 0; a < 2; ++a)
#pragma unroll
            for (int b = 0; b < 2; ++b)
#pragma unroll
                for (int m = 0; m < 4; ++m)
#pragma unroll
                    for (int n = 0; n < 2; ++n) asm volatile("" :: "v"(acc[a][b][m][n]));
    }
};
struct SameUnitOrder { int n, nkt; __device__ bool next(int i, pg8::Unit& u) const { if (i >= n) return false; u.pm = 0; u.pn = 0; u.kt0 = 0; u.nkt = nkt; u.slab = -1; return true; }
    __device__ __forceinline__ void a_ready(const pg8::Unit&) const {} __device__ __forceinline__ void done(const pg8::Unit&) const {} };
#ifndef PROBE_LEAK
#define PROBE_LEAK 0
#endif
#ifndef PROBE_BASE
#define PROBE_BASE 0
#endif
#ifndef PROBE_NULL
#define PROBE_NULL 0
#endif
__global__ void __launch_bounds__(NTHR, 2) mk_fwd(Args kernarg_) {
    ArgsP AP = (ArgsP)__builtin_amdgcn_kernarg_segment_ptr();
    extern __shared__ __attribute__((aligned(16))) unsigned char lds_raw[];
    LAS unsigned char* lds0 = (LAS unsigned char*)lds_raw;
    volatile LAS unsigned* MISC = (volatile LAS unsigned*)(lds0 + MISC_OFF);
    const int tid0 = threadIdx.x, wave0 = __builtin_amdgcn_readfirstlane(tid0 >> 6);
    const int G0 = gridDim.x;
    unsigned char* ws0 = AP->ws;
    for (int u = tid0; u < (LDS_BYTES - LDSCTL_OFF) / 4; u += NTHR) ((LAS unsigned*)(lds0 + LDSCTL_OFF))[u] = 0u;
    __syncthreads();
    XcdBarrier bar; bar.bar = (unsigned*)(ws0 + WS_CTL) + CW_BAR; bar.x = 0; bar.st = nullptr;
    if (!MK_PER_PHASE) bar = xcd_barrier_post((unsigned*)(ws0 + WS_CTL) + CW_BAR, MISC + 8);
    if (tid0 == 0) { const unsigned x = xb_xcc_id(); MISC[10] = x; MISC[11] = MK_PER_PHASE ? 0u : xb_add((unsigned*)(ws0 + WS_CTL) + CW_CENS + 64 * x, 1u); MISC[12] = blockIdx.x; }
    __syncthreads();
    const int lo = AP->ph_lo, hi = AP->ph_hi;
#define IN(k) (lo <= (k) && (k) < hi)
#define NREP(k) (((k) == DUP_PHASE) ? 2 : 1)
#define OPAQUE_TID() int lane = (int)__builtin_amdgcn_mbcnt_hi(~0u, __builtin_amdgcn_mbcnt_lo(~0u, 0u)); asm volatile("" : "+v"(lane)); const int wave = wave0, tid = wave0 * 64 + lane; unsigned char* ws = launder(AP)->ws; int G = G0, bx = (int)MISC[12]; bx = __builtin_amdgcn_readfirstlane(bx); unsigned ldsb = (unsigned)(size_t)lds0; asm volatile("" : "+s"(G), "+s"(bx), "+s"(ldsb)); LAS unsigned char* lds = (LAS unsigned char*)(size_t)ldsb; const int vb = (G % 8 == 0) ? (bx % 8) * (G / 8) + bx / 8 : bx; (void)lane; (void)wave; (void)ws; (void)vb; (void)lds
#define SEAM(k) do { if (!MK_PER_PHASE && IN(k) && IN((k) + 1)) xcd_barrier(bar); } while (0)
    if (IN(0)) { for (int rep = 0; rep < NREP(0); ++rep) { OPAQUE_TID(); p0_prologue(launder(AP), lds, tid, lane, wave, vb, G); if (rep + 1 < NREP(0)) xcd_barrier(bar); } } SEAM(0);
    if (!MK_PER_PHASE && IN(0) && IN(1)) {
        if (tid0 == 0) { unsigned* cen = (unsigned*)(ws0 + WS_CTL) + CW_CENS; const unsigned x = MISC[10], rank = MISC[11]; unsigned nx = 0, xi = 0, n0 = 0; bool eq = true;
            for (unsigned j = 0; j < 16; ++j) { const unsigned c = xb_ld(cen + 64 * j); if (c) { if (!nx) n0 = c; eq = eq && (c == n0); xi += (j < x) ? 1u : 0u; ++nx; } }
            if (nx == 8 && eq && 8 * n0 == (unsigned)G0 && rank < n0) MISC[12] = rank * 8 + xi; }
        __syncthreads();
    }
    for (int l = 0; l < DEPTH; ++l) {
        const int p = 1 + 8 * l;
        if (IN(p + 0)) { for (int rep = 0; rep < NREP(p + 0); ++rep) { OPAQUE_TID(); pg8::Gemm g{(const bf16*)(ws + WS_XB), (const bf16*)(ws + WS_WIN + l * WIN_L), MTOT, INW, DM}; const int Gg = gemm_cus((MTOT / 256) * (INW / 256), G); pg8::StaticOrder S; S.init(MTOT, INW, Gg, bx, DM, WGM_G1);
            pg8::EpiRowScaleBf16 E{(bf16*)(ws + WS_R1), INW, (const float*)(ws + WS_RINV), (float*)(ws + WS_VPART), O5 / 256}; if (bx < Gg) pg8::gemm_phase<pg8::EpiRowScaleBf16, pg8::StaticOrder, true, true>(lds + RING_OFF, g, S, E, tid);
            if (bx >= Gg || Gg == G) conv_helper(launder(AP), ws, lds, 0, l, Gg == G ? bx : bx - Gg, Gg == G ? G : G - Gg, lane, wave); if (rep + 1 < NREP(p + 0)) xcd_barrier(bar); } } SEAM(p + 0);
        if (IN(p + 1)) { for (int rep = 0; rep < NREP(p + 1); ++rep) { OPAQUE_TID(); phase_mixers(launder(AP), l, lds, tid, lane, wave, vb, G); if (rep + 1 < NREP(p + 1)) xcd_barrier(bar); } } SEAM(p + 1);
        if (IN(p + 2)) { for (int rep = 0; rep < NREP(p + 2); ++rep) { OPAQUE_TID(); pg8::Gemm g{(const bf16*)(ws + WS_R2), (const bf16*)(ws + WS_WOUT + l * WOUT_L), MTOT, DM, DM}; const int Gg = G; pg8::SplitTailOrder S; S.init(MTOT, DM, Gg, bx, DM, NSPLIT, WGM_G2);
            pg8::EpiMixTile E{(bf16*)(ws + WS_MIX), DM, (float*)(ws + WS_PART)}; if (bx < Gg) pg8::gemm_phase<pg8::EpiMixTile, pg8::SplitTailOrder, true, true>(lds + RING_OFF, g, S, E, tid);
 if (rep + 1 < NREP(p + 2)) xcd_barrier(bar); } } SEAM(p + 2);
        if (IN(p + 3)) { for (int rep = 0; rep < NREP(p + 3); ++rep) { OPAQUE_TID(); phase_postnorm(launder(AP), AP->g_mix_post + l * DM, l == 0, false, DM, NSPLIT, WGM_G2, lane, wave, vb, G); if (rep + 1 < NREP(p + 3)) xcd_barrier(bar); } } SEAM(p + 3);
        if (PROBE_LEAK && l == 0) { if (blockIdx.x == 0 && tid0 == 0) { MISC[16] = (unsigned)__builtin_amdgcn_s_memtime(); MISC[17] = (unsigned)__builtin_amdgcn_s_memrealtime(); } }
        if (IN(p + 4)) { for (int rep = 0; rep < NREP(p + 4); ++rep) { OPAQUE_TID(); pg8::Gemm g{(const bf16*)(ws + WS_XB), (const bf16*)(ws + WS_WUP + l * WUP_L), MTOT, FF2, DM}; const int Gg = (l + 1 < DEPTH || G3_LAST_CUS == 0) ? gemm_cus((MTOT / 256) * (FF2 / 256), G) : (G3_LAST_CUS < G ? G3_LAST_CUS : G); pg8::StaticOrder S; S.init(MTOT, FF2, Gg, bx, DM, WGM_G3);
            EpiGateConvGelu E{launder(AP), ws, l, (LAS float*)(lds + XCH_OFF)}; if (bx < Gg) pg8::gemm_phase<EpiGateConvGelu, pg8::StaticOrder, true, true>(lds + RING_OFF, g, S, E, tid);
            if (bx >= Gg || Gg == G) conv_helper(launder(AP), ws, lds, 2, l, Gg == G ? bx : bx - Gg, Gg == G ? G : G - Gg, lane, wave); if (rep + 1 < NREP(p + 4)) xcd_barrier(bar); } } SEAM(p + 4);
        if (PROBE_LEAK && l == 0) { if (blockIdx.x == 0 && tid0 == 0) { MISC[18] = (unsigned)__builtin_amdgcn_s_memtime() - MISC[16]; MISC[19] = (unsigned)__builtin_amdgcn_s_memrealtime() - MISC[17]; } }
        if (PROBE_NULL && l == 0) { OPAQUE_TID(); xcd_barrier(bar);
            const int N_ = PROBE_NULL == 1 ? INW : (PROBE_NULL == 3 ? FF2 : DM), K_ = PROBE_NULL == 4 ? FF : DM;
            const bf16* A_ = (const bf16*)(ws + ((PROBE_NULL == 1 || PROBE_NULL == 3) ? WS_XB : WS_R2)); const bf16* B_ = (const bf16*)(ws + (PROBE_NULL == 1 ? WS_WIN : PROBE_NULL == 2 ? WS_WOUT : PROBE_NULL == 3 ? WS_WUP : WS_WDN));
            pg8::Gemm g{A_, B_, MTOT, N_, K_}; EpiNull E{};
            if (PROBE_NULL == 6) { SameUnitOrder S{2, 88}; pg8::Gemm g6{(const bf16*)(ws + WS_R2), (const bf16*)(ws + WS_WDN), MTOT, DM, FF}; pg8::gemm_phase<EpiNull, SameUnitOrder, true, true>(lds + RING_OFF, g6, S, E, tid); }
            else if (PROBE_NULL == 7) { pg8::SplitTailOrder S; S.init(MTOT, DM, G, bx, FF, NSPLIT); pg8::Gemm g7{(const bf16*)(ws + WS_R2), (const bf16*)(ws + WS_WDN), MTOT, DM, FF}; pg8::gemm_phase<EpiNull, pg8::SplitTailOrder, true, true>(lds + RING_OFF, g7, S, E, tid); }
            else if (PROBE_NULL == 5) { SameUnitOrder S{7, 32}; pg8::Gemm g5{(const bf16*)(ws + WS_XB), (const bf16*)(ws + WS_WUP), MTOT, FF2, DM}; pg8::gemm_phase<EpiNull, SameUnitOrder, true, true>(lds + RING_OFF, g5, S, E, tid); }
            else { pg8::StaticOrder S; S.init(MTOT, N_, G, bx, K_); pg8::gemm_phase<EpiNull, pg8::StaticOrder, true, true>(lds + RING_OFF, g, S, E, tid); }
            xcd_barrier(bar); }
        if (IN(p + 5)) { for (int rep = 0; rep < NREP(p + 5); ++rep) { OPAQUE_TID(); phase_halofix(launder(AP), l, tid, vb, G); if (rep + 1 < NREP(p + 5)) xcd_barrier(bar); } } SEAM(p + 5);
        if (IN(p + 6)) { for (int rep = 0; rep < NREP(p + 6); ++rep) { OPAQUE_TID(); pg8::Gemm g{(const bf16*)(ws + WS_R2), (const bf16*)(ws + WS_WDN + l * WDN_L), MTOT, DM, FF}; pg8::SplitTailOrder S; S.init(MTOT, DM, G, bx, FF, NSPLIT, WGM_G4);
            pg8::EpiMixTile E{(bf16*)(ws + WS_MIX), DM, (float*)(ws + WS_PART)}; pg8::gemm_phase<pg8::EpiMixTile, pg8::SplitTailOrder, true, true>(lds + RING_OFF, g, S, E, tid); if (rep + 1 < NREP(p + 6)) xcd_barrier(bar); } } SEAM(p + 6);
        if (IN(p + 7)) { for (int rep = 0; rep < NREP(p + 7); ++rep) { OPAQUE_TID(); phase_postnorm(launder(AP), AP->g_ffn_post + l * DM, false, l + 1 == DEPTH, FF, NSPLIT, WGM_G4, lane, wave, vb, G); if (rep + 1 < NREP(p + 7)) xcd_barrier(bar); } } SEAM(p + 7);
    }
    if (PROBE_LEAK) { if (blockIdx.x == 0 && tid0 == 0) { const float cyc = (float)MISC[18], rt = (float)MISC[19]; const float v = PROBE_LEAK == 1 ? cyc / rt * 100.f   : (PROBE_LEAK == 2 ? rt * 0.01f   : cyc * (1.f / 224.f)  ); AP->out[OUT_VS] = 32.f * floorf((v - (float)PROBE_BASE) * (1.f / 32.f) + 0.5f) + 1000.f;     } }
#undef IN
#undef SEAM
}

extern "C" void kernel_launch(void* const* d_in, const int* in_sizes, int n_in, void* d_out, int out_size, void* d_ws, size_t ws_size, hipStream_t stream) {
    static int grid = 0;
    if (grid == 0) {
        if (n_in != 21 || out_size != (int)OUT_END || ws_size < WS_END) { fprintf(stderr, "kernel_launch: unexpected sizes n_in %d out %d ws %zu (need %zu)\n", n_in, out_size, ws_size, (size_t)WS_END); grid = -1; return; }
        int dev = 0, cus = 0, per_cu = 0;
        if (hipGetDevice(&dev) != hipSuccess || hipDeviceGetAttribute(&cus, hipDeviceAttributeMultiprocessorCount, dev) != hipSuccess) { grid = -1; return; }
        if (hipFuncSetAttribute((const void*)mk_fwd, hipFuncAttributeMaxDynamicSharedMemorySize, LDS_BYTES) != hipSuccess) { fprintf(stderr, "kernel_launch: hipFuncSetAttribute failed\n"); grid = -1; return; }
        if (hipOccupancyMaxActiveBlocksPerMultiprocessor(&per_cu, (const void*)mk_fwd, NTHR, LDS_BYTES) != hipSuccess || per_cu < 1) { fprintf(stderr, "kernel_launch: occupancy query says %d blocks per CU\n", per_cu); (void)hipGetLastError(); grid = -1; return; }
        grid = cus;
    }
    if (grid < 0) return;
    if (hipMemsetAsync((char*)d_ws + WS_CTL, 0, CTL_ZERO_BYTES, stream) != hipSuccess) { fprintf(stderr, "kernel_launch: memset failed\n"); return; }
    Args a{};
    const float** ap = (const float**)&a;
    for (int i = 0; i < 21; ++i) ap[i] = (const float*)d_in[i];
    a.out = (float*)d_out; a.ws = (unsigned char*)d_ws;
#if MK_PER_PHASE
    for (int p = 0; p < NPHASE; ++p) { a.ph_lo = p; a.ph_hi = p + 1; hipLaunchKernelGGL(mk_fwd, dim3(grid), dim3(NTHR), LDS_BYTES, stream, a); }
#else
    a.ph_lo = 0; a.ph_hi = NPHASE;
#if MK_COOP_LAUNCH
    void* kargs[] = {&a};
    hipError_t e = hipLaunchCooperativeKernel((const void*)mk_fwd, dim3(grid), dim3(NTHR), kargs, LDS_BYTES, stream);
    if (e != hipSuccess) fprintf(stderr, "kernel_launch: cooperative launch failed: %s (grid %d)\n", hipGetErrorString(e), grid);
#else
    hipLaunchKernelGGL(mk_fwd, dim3(grid), dim3(NTHR), LDS_BYTES, stream, a);
    hipError_t e = hipPeekAtLastError(); if (e != hipSuccess) fprintf(stderr, "kernel_launch: launch failed: %s (grid %d)\n", hipGetErrorString(e), grid);
#endif
#endif
}
```

```cpp
#include <hip/hip_runtime.h>
#include <cstdio>
#include <cstdint>
namespace pg8 {
#define PG8_LAS __attribute__((address_space(3)))
typedef unsigned short bf16_t;
typedef short bf16x8 __attribute__((ext_vector_type(8)));
typedef float f32x4 __attribute__((ext_vector_type(4)));
typedef unsigned u32x4 __attribute__((ext_vector_type(4)));
constexpr int BM = 256, BK = 64, HALF = 128, HTB = HALF * BK * 2  , STAGE_BYTES = 8 * HTB, NXCD = 8, WGM = 4;

__host__ __device__ __forceinline__ int lds_byte(int r, int c) { const int st = (r >> 4) * 2 + (c >> 5), rr = r & 15, cc = c & 31, ob = rr * 64 + cc * 2; return st * 1024 + (ob ^ (((ob >> 9) & 1) << 5)); }
__host__ __device__ __forceinline__ void stage_rc(int b, int& R, int& C) { const int st = b / 1024, sb = b % 1024, swz = sb ^ (((sb >> 9) & 1) << 5); R = (st >> 1) * 16 + swz / 64; C = (st & 1) * 32 + (swz % 64) / 2; }
__host__ __device__ __forceinline__ int perm32(int rho) { const int n = rho >> 4, i = rho & 15; return 8 * (i >> 2) + 4 * n + (i & 3); }

struct Unit { int pm, pn, kt0, nkt, slab; };
struct Gemm { const bf16_t* A; const bf16_t* Bt; int M, N, K; };

struct StaticOrder {
    int nM, nN, nwg, G, c, nkt, wgm;
    __host__ __device__ void init(int M, int N, int G_, int c_, int K, int wgm_ = WGM) { nM = M / BM; nN = N / BM; nwg = nM * nN; G = G_; c = c_; nkt = K / BK; wgm = wgm_; }
    __host__ __device__ bool next(int i, Unit& u) const {
        const long L = (long)i * G + c; if (L >= nwg) return false; u.kt0 = 0; u.nkt = nkt; u.slab = -1;
        int wgid = (int)L; { const int q = nwg / NXCD, r = nwg % NXCD, xcd = wgid % NXCD, off = wgid / NXCD; wgid = (xcd < r ? xcd * (q + 1) : r * (q + 1) + (xcd - r) * q) + off; }
        const int nig = wgm * nN, gid = wgid / nig, fm = gid * wgm, gsz = (nM - fm) < wgm ? (nM - fm) : wgm;
        u.pm = fm + ((wgid % nig) % gsz); u.pn = (wgid % nig) / gsz; return true;
    }
    __device__ __forceinline__ void a_ready(const Unit&) const {}
    __device__ __forceinline__ void done(const Unit&) const {}
};

struct SplitTailOrder : StaticOrder {
    int ns, ntail, nfull;
    __host__ __device__ void init(int M, int N, int G_, int c_, int K, int ns_, int wgm_ = WGM) { StaticOrder::init(M, N, G_, c_, K, wgm_); nfull = nwg / G; ntail = nwg - nfull * G; ns = ns_; if (ntail == 0 || ns * ntail > G || ns > nkt / 2) ns = 1; }
    __host__ __device__ bool next(int i, Unit& u) const {
        if (i < nfull || ns == 1) return StaticOrder::next(i, u);
        if (i > nfull) return false;
        const int ti = c % ntail, s = c / ntail; if (s >= ns) return false;
        StaticOrder t = *this; t.c = ti; if (!t.StaticOrder::next(nfull, u)) return false;
        const int h = nkt / 2, k0 = 2 * ((s * h) / ns), k1 = 2 * (((s + 1) * h) / ns); u.kt0 = k0; u.nkt = k1 - k0; u.slab = ti * ns + s; return true;
    }
    __host__ __device__ int tail_slot(int pm, int pn) const {
        if (ns == 1) return -1;
        const int gid = pm / wgm, fm = gid * wgm, gsz = (nM - fm) < wgm ? (nM - fm) : wgm; const int wgid = gid * wgm * nN + pn * gsz + (pm - fm);
        const int q = nwg / NXCD, r = nwg % NXCD; int xcd, off; if (wgid < r * (q + 1)) { xcd = wgid / (q + 1); off = wgid % (q + 1); } else { const int w2 = wgid - r * (q + 1); xcd = r + w2 / q; off = w2 % q; }
        const long L = (long)off * NXCD + xcd; if (L < (long)nfull * G) return -1; return (int)(L - (long)nfull * G) * ns;
    }
};

typedef float f32x2c __attribute__((ext_vector_type(2))); typedef __bf16 bf16x2c __attribute__((ext_vector_type(2)));
__device__ __forceinline__ unsigned cvt_pk_bf16(float lo, float hi) { const f32x2c v = {lo, hi}; return __builtin_bit_cast(unsigned, __builtin_convertvector(v, bf16x2c)); }
struct EpiRowScaleBf16 {
    static constexpr bool PERM = true, AFTER_DRAIN = false;
    bf16_t* O; int ldc; const float* rs; float* vpart; int pn0;
    __device__ __forceinline__ void operator()(const f32x4 (&acc)[2][2][4][2], const Unit& u, int wr, int wc, int fr, int fq) const {
        const int row0 = u.pm * BM + wr * 64 + fr, col0 = u.pn * BM + wc * 32 + 8 * fq; const bool want_ssq = u.pn >= pn0;
        float sv[2][4];
#pragma unroll
        for (int ai = 0; ai < 2; ++ai)
#pragma unroll
            for (int m = 0; m < 4; ++m) sv[ai][m] = rs[row0 + ai * HALF + m * 16];
#pragma unroll
        for (int ai = 0; ai < 2; ++ai)
#pragma unroll
            for (int m = 0; m < 4; ++m) { const int r = row0 + ai * HALF + m * 16; const float s = sv[ai][m]; bf16_t* rowp = O + (size_t)r * ldc + col0;
#pragma unroll
                for (int bj = 0; bj < 2; ++bj) { const f32x4 v0 = acc[ai][bj][m][0] * s, v1 = acc[ai][bj][m][1] * s;
                    u32x4 w; w.x = cvt_pk_bf16(v0[0], v0[1]); w.y = cvt_pk_bf16(v0[2], v0[3]); w.z = cvt_pk_bf16(v1[0], v1[1]); w.w = cvt_pk_bf16(v1[2], v1[3]);
                    *(u32x4*)(rowp + bj * HALF) = w; }
                if (want_ssq) { float q = 0.f;
#pragma unroll
                    for (int bj = 0; bj < 2; ++bj)
#pragma unroll
                        for (int n = 0; n < 2; ++n) { const f32x4 x = acc[ai][bj][m][n] * s; q += (x[0] * x[0] + x[1] * x[1]) + (x[2] * x[2] + x[3] * x[3]); }
                    q += __shfl_xor(q, 16); q += __shfl_xor(q, 32);
                    if (fq == 0) vpart[(size_t)r * 12 + (u.pn - pn0) * 4 + wc] = q; } }
    }
};
struct EpiMixTile {
    static constexpr bool PERM = true, AFTER_DRAIN = false;
    bf16_t* O; int ldc; float* part;
    __device__ __forceinline__ void operator()(const f32x4 (&acc)[2][2][4][2], const Unit& u, int wr, int wc, int fr, int fq) const {
        const bool sl = u.slab >= 0; const size_t ld = sl ? (size_t)BM : (size_t)ldc;
        { bf16_t* base = sl ? (bf16_t*)part + (size_t)u.slab * (BM * BM) + (size_t)(wr * 64 + fr) * BM + wc * 32 + 8 * fq : O + (size_t)(u.pm * BM + wr * 64 + fr) * ldc + u.pn * BM + wc * 32 + 8 * fq;
#pragma unroll
            for (int ai = 0; ai < 2; ++ai)
#pragma unroll
                for (int m = 0; m < 4; ++m) { bf16_t* rowp = base + (size_t)(ai * HALF + m * 16) * ld;
#pragma unroll
                    for (int bj = 0; bj < 2; ++bj) { const f32x4 v0 = acc[ai][bj][m][0], v1 = acc[ai][bj][m][1];
                        u32x4 w; w.x = cvt_pk_bf16(v0[0], v0[1]); w.y = cvt_pk_bf16(v0[2], v0[3]); w.z = cvt_pk_bf16(v1[0], v1[1]); w.w = cvt_pk_bf16(v1[2], v1[3]);
                        *(u32x4*)(rowp + bj * HALF) = w; } }
        }
    }
};

template <class Epi, class Sched, bool ALIGN_EPI = false, bool SP2 = false>
__device__ __forceinline__ void gemm_phase(PG8_LAS unsigned char* lds, const Gemm g, const Sched& S, const Epi& E, const int tid_in  ) {
    const int tid = tid_in, wid = __builtin_amdgcn_readfirstlane(tid >> 6), lane = tid & 63, wr = wid >> 2, wc = wid & 3, fr = lane & 15, fq = lane >> 4;
    const int K = g.K;
    unsigned voffA[2], voffB[2];
#pragma unroll
    for (int i = 0; i < 2; ++i) { int R, C; stage_rc(tid * 16 + i * 8192, R, C); const int Rb = Epi::PERM ? ((R & ~31) + perm32(R & 31)) : R;
        voffA[i] = (unsigned)(R * K + C) * 2u; voffB[i] = (unsigned)(Rb * K + C) * 2u; }
    const size_t kstep = (size_t)(BK * 2);
    const size_t hstep = (size_t)HALF * K * 2;
    const size_t tstep = 2 * hstep;
    const unsigned ldsw = (unsigned)wid * 1024u;
    const int aoff = lds_byte(wr * 64 + fr, fq * 8), boff = lds_byte(wc * 32 + fr, fq * 8);
#define PG8_SA(b, h) (((b) * 2 + (h)) * HTB)
#define PG8_SB(b, h) ((4 + (b) * 2 + (h)) * HTB)
#define PG8_STAGE(bufoff, gbase, voff) do { _Pragma("unroll") for (int _i = 0; _i < 2; ++_i) \
        __builtin_amdgcn_global_load_lds((const unsigned*)((const char*)(gbase) + (voff)[_i]), (PG8_LAS unsigned*)(lds + (bufoff) + ldsw + _i * 8192), 16, 0, 0); } while (0)
#define PG8_LDA(dst, b, h) do { _Pragma("unroll") for (int m = 0; m < 4; ++m) _Pragma("unroll") for (int k = 0; k < 2; ++k) dst[m][k] = *(const PG8_LAS bf16x8*)(lds + PG8_SA(b, h) + aoff + m * 2048 + k * 1024); } while (0)
#define PG8_LDB(dst, b, h) do { _Pragma("unroll") for (int n = 0; n < 2; ++n) _Pragma("unroll") for (int k = 0; k < 2; ++k) dst[n][k] = *(const PG8_LAS bf16x8*)(lds + PG8_SB(b, h) + boff + n * 2048 + k * 1024); } while (0)
#define PG8_MMA(ai, bj, At, Bt) do { __builtin_amdgcn_s_setprio(1); _Pragma("unroll") for (int m = 0; m < 4; ++m) _Pragma("unroll") for (int n = 0; n < 2; ++n) _Pragma("unroll") for (int k = 0; k < 2; ++k) \
        acc[ai][bj][m][n] = __builtin_amdgcn_mfma_f32_16x16x32_bf16(Bt[n][k], At[m][k], acc[ai][bj][m][n], 0, 0, 0); __builtin_amdgcn_s_setprio(0); } while (0)
#define PG8_WAIT_V(n) asm volatile("s_waitcnt vmcnt(" #n ")" ::: "memory")
#define PG8_WAIT_L(n) asm volatile("s_waitcnt lgkmcnt(" #n ")" ::: "memory")
#define PG8_BAR __builtin_amdgcn_s_barrier()
#define PG8_SCHED __builtin_amdgcn_sched_barrier(0)
    Unit cur, nxt; int ui = 0;
    if (!S.next(0, cur)) return;
    f32x4 acc[2][2][4][2];
#pragma unroll
    for (int a = 0; a < 2; ++a)
#pragma unroll
        for (int b = 0; b < 2; ++b)
#pragma unroll
            for (int m = 0; m < 4; ++m)
#pragma unroll
                for (int n = 0; n < 2; ++n) acc[a][b][m][n] = (f32x4){0.f, 0.f, 0.f, 0.f};
    bf16x8 At[4][2], B0[2][2], B1[2][2];
    const char* cA = (const char*)g.A + (size_t)cur.pm * tstep + (size_t)cur.kt0 * kstep; const char* cB = (const char*)g.Bt + (size_t)cur.pn * tstep + (size_t)cur.kt0 * kstep;
    S.a_ready(cur);
    if constexpr (SP2) {
        PG8_STAGE(PG8_SB(0, 0), cB, voffB); PG8_STAGE(PG8_SB(0, 1), cB + hstep, voffB); PG8_STAGE(PG8_SA(0, 0), cA, voffA); PG8_STAGE(PG8_SA(0, 1), cA + hstep, voffA);
        if (wr == 1) PG8_BAR;
        PG8_WAIT_V(2); PG8_BAR;
        PG8_STAGE(PG8_SB(1, 0), cB + kstep, voffB); PG8_STAGE(PG8_SA(1, 0), cA + kstep, voffA); PG8_STAGE(PG8_SB(1, 1), cB + hstep + kstep, voffB);
        PG8_WAIT_V(6); PG8_BAR;
    } else {
        PG8_STAGE(PG8_SB(0, 0), cB, voffB); PG8_STAGE(PG8_SA(0, 0), cA, voffA); PG8_STAGE(PG8_SB(0, 1), cB + hstep, voffB); PG8_STAGE(PG8_SA(0, 1), cA + hstep, voffA);
        if (wr == 1) PG8_BAR;
        PG8_WAIT_V(4); PG8_BAR;
        PG8_STAGE(PG8_SB(1, 0), cB + kstep, voffB); PG8_STAGE(PG8_SA(1, 0), cA + kstep, voffA); PG8_STAGE(PG8_SB(1, 1), cB + hstep + kstep, voffB);
        PG8_WAIT_V(6); PG8_BAR;
    }
    for (;;) {
        const bool has_next = S.next(ui + 1, nxt);
        const char* nA = has_next ? (const char*)g.A + (size_t)nxt.pm * tstep + (size_t)nxt.kt0 * kstep : cA; const char* nB = has_next ? (const char*)g.Bt + (size_t)nxt.pn * tstep + (size_t)nxt.kt0 * kstep : cB;
        const int ntc = cur.nkt;
        for (int t = 0; t < ntc; t += 2) {
            const bool last = (t == ntc - 2);
            const char* a1 = cA + (size_t)(t + 1) * kstep;
            const char* a2 = last ? nA : cA + (size_t)(t + 2) * kstep; const char* b2 = last ? nB : cB + (size_t)(t + 2) * kstep;
            const char* a3 = a2 + kstep; const char* b3 = b2 + kstep;
            if (last && has_next) S.a_ready(nxt);
            if constexpr (SP2) {
            PG8_LDB(B0, 0, 0); PG8_LDB(B1, 0, 1); PG8_SCHED; PG8_LDA(At, 0, 0); PG8_STAGE(PG8_SA(1, 1), a1 + hstep, voffA);
            PG8_WAIT_V(8); PG8_WAIT_L(0); PG8_BAR; PG8_MMA(0, 0, At, B0); PG8_MMA(0, 1, At, B1); PG8_BAR; PG8_SCHED;
            PG8_LDA(At, 0, 1); PG8_STAGE(PG8_SB(0, 0), b2, voffB); PG8_STAGE(PG8_SB(0, 1), b2 + hstep, voffB); PG8_STAGE(PG8_SA(0, 0), a2, voffA);
            PG8_WAIT_V(8); PG8_WAIT_L(0); PG8_BAR; PG8_MMA(1, 0, At, B0); PG8_MMA(1, 1, At, B1); PG8_BAR; PG8_SCHED;
            PG8_LDB(B0, 1, 0); PG8_LDB(B1, 1, 1); PG8_SCHED; PG8_LDA(At, 1, 0); PG8_STAGE(PG8_SA(0, 1), a2 + hstep, voffA);
            PG8_WAIT_V(8); PG8_WAIT_L(0); PG8_BAR; PG8_MMA(0, 0, At, B0); PG8_MMA(0, 1, At, B1); PG8_BAR; PG8_SCHED;
            PG8_LDA(At, 1, 1); PG8_STAGE(PG8_SB(1, 0), b3, voffB); PG8_STAGE(PG8_SB(1, 1), b3 + hstep, voffB); PG8_STAGE(PG8_SA(1, 0), a3, voffA);
            PG8_WAIT_V(8); PG8_WAIT_L(0); PG8_BAR; PG8_MMA(1, 0, At, B0); PG8_MMA(1, 1, At, B1); PG8_BAR; PG8_SCHED;
            } else {
            PG8_LDB(B0, 0, 0); PG8_SCHED; PG8_LDA(At, 0, 0); PG8_STAGE(PG8_SA(1, 1), a1 + hstep, voffA);
            PG8_WAIT_L(8); PG8_BAR; PG8_WAIT_L(0); PG8_MMA(0, 0, At, B0); PG8_BAR; PG8_SCHED;
            PG8_LDB(B1, 0, 1); PG8_STAGE(PG8_SB(0, 0), b2, voffB);
            PG8_BAR; PG8_WAIT_L(0); PG8_MMA(0, 1, At, B1); PG8_BAR;
            PG8_LDA(At, 0, 1); PG8_STAGE(PG8_SA(0, 0), a2, voffA);
            PG8_BAR; PG8_WAIT_L(0); PG8_MMA(1, 0, At, B0); PG8_BAR; PG8_SCHED;
            PG8_STAGE(PG8_SB(0, 1), b2 + hstep, voffB);
            PG8_WAIT_V(6); PG8_BAR; PG8_MMA(1, 1, At, B1); PG8_BAR;
            PG8_LDB(B0, 1, 0); PG8_SCHED; PG8_LDA(At, 1, 0); PG8_STAGE(PG8_SA(0, 1), a2 + hstep, voffA);
            PG8_WAIT_L(8); PG8_BAR; PG8_WAIT_L(0); PG8_MMA(0, 0, At, B0); PG8_BAR; PG8_SCHED;
            PG8_LDB(B1, 1, 1); PG8_STAGE(PG8_SB(1, 0), b3, voffB);
            PG8_BAR; PG8_WAIT_L(0); PG8_MMA(0, 1, At, B1); PG8_BAR;
            PG8_LDA(At, 1, 1); PG8_STAGE(PG8_SA(1, 0), a3, voffA);
            PG8_BAR; PG8_WAIT_L(0); PG8_MMA(1, 0, At, B0); PG8_BAR; PG8_SCHED;
            PG8_STAGE(PG8_SB(1, 1), b3 + hstep, voffB);
            PG8_WAIT_V(6); PG8_BAR; PG8_MMA(1, 1, At, B1); PG8_BAR;
            }
        }
        if constexpr (ALIGN_EPI) { if (wr == 0) PG8_BAR; }
        if constexpr (!Epi::AFTER_DRAIN) { E(acc, cur, wr, wc, fr, fq); S.done(cur); }
        if (!has_next) break;
#pragma unroll
        for (int a = 0; a < 2; ++a)
#pragma unroll
            for (int b = 0; b < 2; ++b)
#pragma unroll
                for (int m = 0; m < 4; ++m)
#pragma unroll
                    for (int n = 0; n < 2; ++n) acc[a][b][m][n] = (f32x4){0.f, 0.f, 0.f, 0.f};
        cur = nxt; cA = nA; cB = nB; ++ui;
        if constexpr (ALIGN_EPI) { if (wr == 1) PG8_BAR; }
    }
    PG8_WAIT_V(0);
    if constexpr (!ALIGN_EPI) { if (wr == 0) PG8_BAR; }
    PG8_BAR;
    if constexpr (Epi::AFTER_DRAIN) { E.fused(acc, cur, wr, wc, fr, fq, lds, wid, lane); S.done(cur); }
#undef PG8_SA
#undef PG8_SB
#undef PG8_STAGE
#undef PG8_LDA
#undef PG8_LDB
#undef PG8_MMA
#undef PG8_WAIT_V
#undef PG8_WAIT_L
#undef PG8_BAR
#undef PG8_SCHED
}
}
#define GAS __attribute__((address_space(1)))
#define LAS __attribute__((address_space(3)))
typedef unsigned short bf16;
typedef unsigned v4u __attribute__((ext_vector_type(4)));
typedef float f32x4 __attribute__((ext_vector_type(4)));
typedef short bf16x8 __attribute__((ext_vector_type(8)));
typedef GAS unsigned gu32;
typedef GAS unsigned long long gu64;
#define RLX_AGENT __ATOMIC_RELAXED, __HIP_MEMORY_SCOPE_AGENT
#define LDS_WAIT() asm volatile("s_waitcnt lgkmcnt(0)" ::: "memory")
#define VM_WAIT() asm volatile("s_waitcnt vmcnt(0)" ::: "memory")
__device__ __forceinline__ unsigned long long rt() { return __builtin_amdgcn_s_memrealtime(); }
__device__ __forceinline__ unsigned pk2(float lo, float hi) { return pg8::cvt_pk_bf16(lo, hi); }
__device__ __forceinline__ unsigned f2bf(float f) { return pg8::cvt_pk_bf16(f, 0.f) & 0xffffu; }

#define XB_TMO      128
#define XB_XCNT(j)  (256  + 64 * (j))
#define XB_XSUB(j)  (1280 + 64 * (j))
#define XB_XGEN(j)  (2304 + 64 * (j))
#define XB_TOP      3328
#define XB_TOPGEN   3392
#define XCD_BAR_WORDS 3456
#define XB_SPIN_CAP (1u << 18)

__device__ __forceinline__ unsigned xb_ld(unsigned* p)              { return __hip_atomic_load(p, __ATOMIC_RELAXED, __HIP_MEMORY_SCOPE_AGENT); }
__device__ __forceinline__ unsigned xb_add(unsigned* p, unsigned v) { return __hip_atomic_fetch_add(p, v, __ATOMIC_RELAXED, __HIP_MEMORY_SCOPE_AGENT); }
__device__ __forceinline__ unsigned xb_xcc_id() { return (unsigned)__builtin_amdgcn_s_getreg((3 << 11) | 20) & 0xFu; }
#define XB_SPIN(cond, bar) do { unsigned _sp = 0; while (cond) { __builtin_amdgcn_s_sleep(1); \
    if ((++_sp & 255u) == 0u) { if (xb_ld(&(bar)[XB_TMO])) break; if (_sp > XB_SPIN_CAP) { atomicAdd(&(bar)[XB_TMO], 1u); break; } } } } while (0)

struct XcdBarrier {
    unsigned* bar; unsigned x;
    volatile LAS unsigned* st;
};

__device__ __forceinline__ XcdBarrier xcd_barrier_post(unsigned* bar, volatile LAS unsigned* st) {
    XcdBarrier b; b.bar = bar; b.x = xb_xcc_id(); b.st = st;
    if (threadIdx.x == 0) (void)xb_add(&bar[XB_XCNT(b.x)], 1u);
    return b;
}
__device__ __forceinline__ void xcd_barrier_complete(unsigned* bar, unsigned x, unsigned& nloc, unsigned& nx) {
    const unsigned G = gridDim.x * gridDim.y * gridDim.z;
    unsigned sum, cnt, mine, sp = 0u;
    for (;;) {
        sum = 0u; cnt = 0u; mine = 0u;
#pragma unroll
        for (unsigned j = 0; j < 16; ++j) { const unsigned c = xb_ld(&bar[XB_XCNT(j)]); sum += c; cnt += (c > 0u) ? 1u : 0u; mine = (j == x) ? c : mine; }
        if (sum == G) break;
        __builtin_amdgcn_s_sleep(1);
        if ((++sp & 255u) == 0u) { if (xb_ld(&bar[XB_TMO])) break; if (sp > XB_SPIN_CAP) { atomicAdd(&bar[XB_TMO], 1u); break; } }
    }
    nloc = mine > 0u ? mine : 1u; nx = cnt > 0u ? cnt : 1u;
}

__device__ __forceinline__ void xcd_barrier(const XcdBarrier& b) {
    asm volatile("s_waitcnt vmcnt(0)" ::: "memory");
    __syncthreads();
    if (threadIdx.x == 0) {
        unsigned* bar = b.bar;
        __builtin_amdgcn_s_waitcnt(0);
        unsigned nloc = b.st[0], nx = b.st[1];
        if (nloc == 0u) { xcd_barrier_complete(bar, b.x, nloc, nx); b.st[0] = nloc; b.st[1] = nx; }
        const unsigned old = xb_add(&bar[XB_XSUB(b.x)], 1u);
        const unsigned gen = old / nloc;
        if (old + 1u == (gen + 1u) * nloc) {
            __builtin_amdgcn_fence(__ATOMIC_RELEASE, "agent");
            asm volatile("s_waitcnt vmcnt(0)" ::: "memory");
            const unsigned og = xb_add(&bar[XB_TOP], 1u);
            const unsigned tg = og / nx;
            if (og + 1u == (tg + 1u) * nx) xb_add(&bar[XB_TOPGEN], 1u);
            else XB_SPIN(xb_ld(&bar[XB_TOPGEN]) == tg, bar);
            __builtin_amdgcn_fence(__ATOMIC_ACQUIRE, "agent");
            xb_add(&bar[XB_XGEN(b.x)], 1u);
            asm volatile("s_waitcnt vmcnt(0)" ::: "memory");
        } else {
            XB_SPIN(xb_ld(&bar[XB_XGEN(b.x)]) == gen, bar);
            __builtin_amdgcn_fence(__ATOMIC_ACQUIRE, "agent");
            asm volatile("s_waitcnt vmcnt(0)" ::: "memory");
        }
    }
    __syncthreads();
}

#ifndef DUP_PHASE
#define DUP_PHASE -1
#endif
#ifndef MK_COOP_LAUNCH
#define MK_COOP_LAUNCH 1
#endif
#ifndef MK_PER_PHASE
#define MK_PER_PHASE 0
#endif
constexpr int NWAVES = 8, NTHR = NWAVES * 64;
constexpr int DM = 2048, MP = 8192, MS = 1024, MTOT = MP + MS, SEQ = 2048, NBAT = 4, DBAT = 128, DSEQ = 8, DEPTH = 2;
constexpr int PW = 512, CW = 768, SW = 768, INW = 4352, FF = 5632, FF2 = 2 * FF, PHIST = 15;
constexpr int O1 = 512, O2 = 1280, O3 = 2048, O4 = 2816, O5 = 3584;
constexpr float EPS = 1e-6f;
#ifndef MIX_DUP
#define MIX_DUP 0
#endif
#ifndef G3_LAST_CUS
#define G3_LAST_CUS 0
#endif
#ifndef WGM_G1
#define WGM_G1 4
#endif
#ifndef WGM_G2
#define WGM_G2 4
#endif
#ifndef WGM_G3
#define WGM_G3 4
#endif
#ifndef WGM_G4
#define WGM_G4 4
#endif
constexpr int NPHASE = 1 + 8 * DEPTH, NSPLIT = 8;
constexpr size_t OUT_POOLP = (size_t)MTOT * DM, OUT_POOLS = OUT_POOLP + (size_t)DEPTH * NBAT * PHIST * PW, OUT_CONVP = OUT_POOLS + (size_t)DEPTH * DBAT * PHIST * PW,
                 OUT_CONVS = OUT_CONVP + (size_t)DEPTH * NBAT * 2 * CW, OUT_FFNP = OUT_CONVS + (size_t)DEPTH * DBAT * 2 * CW, OUT_FFNS = OUT_FFNP + (size_t)DEPTH * NBAT * 2 * FF,
                 OUT_VS = OUT_FFNS + (size_t)DEPTH * DBAT * 2 * FF, OUT_END = OUT_VS + (size_t)DEPTH * DBAT * DSEQ * SW;
static_assert(OUT_END == 25853952, "d_out map");
constexpr size_t MiB = 1u << 20;
constexpr size_t WS_CTL = 0, CTL_ZERO_BYTES = 64 * 1024;
constexpr size_t WS_WIN = 1 * MiB, WIN_L = 17 * MiB, WS_WOUT = 35 * MiB, WOUT_L = 8 * MiB, WS_WUP = 51 * MiB, WUP_L = 44 * MiB, WS_WDN = 139 * MiB, WDN_L = 22 * MiB;
constexpr size_t WS_SGUW = 183 * MiB, WS_RINV = 184 * MiB, WS_SSQP = 185 * MiB, WS_XB = 187 * MiB, WS_MIX = 223 * MiB, WS_R1 = 295 * MiB, WS_R2 = 493 * MiB, WS_HALO = 592 * MiB, WS_SHALO = 598 * MiB, WS_PART = 610 * MiB, WS_END = 674 * MiB;
constexpr size_t HALO_SZ = (size_t)32 * 2 * FF;
constexpr size_t SHALO_SZ = (size_t)DBAT * 2 * FF;
static_assert(3 * HALO_SZ * 4 <= 6 * MiB && 2 * SHALO_SZ * 4 <= 12 * MiB, "halo buffers");
static_assert((size_t)INW * DM * 2 == WIN_L && (size_t)DM * DM * 2 == WOUT_L && (size_t)FF2 * DM * 2 == WUP_L && (size_t)DM * FF * 2 == WDN_L, "weight copies");
static_assert((size_t)MTOT * DM * 2 == 36 * MiB && (size_t)MTOT * DM * 4 == 72 * MiB && (size_t)MTOT * FF2 * 2 == 198 * MiB && (size_t)MTOT * FF * 2 == 99 * MiB, "activation buffers");
constexpr size_t WS_VPART = WS_SSQP + 1536 * 1024;
static_assert((size_t)MTOT * 32 * 4 <= 1536 * 1024 && (size_t)MTOT * 12 * 4 <= 512 * 1024, "ssq partial buffers");
constexpr int CW_BAR = 4096, CW_CENS = 8192;
static_assert((CW_CENS + 16 * 64) * 4 <= (int)CTL_ZERO_BYTES && (CW_BAR + 3456) <= CW_CENS, "control words inside the zeroed region");
constexpr int RING_OFF = 0, RING_BYTES = 131072, LDSCTL_OFF = RING_BYTES, MISC_OFF = LDSCTL_OFF + 320, XCH_OFF = RING_BYTES + 1024  , LDS_BYTES = 147456;

struct Args {
    const float *x_prompt, *x_sample, *state_pool, *state_conv, *state_ffn, *g_mix_pre, *g_mix_post, *g_ffn_pre, *g_ffn_post, *w_in, *pool_w, *pool_scale, *conv_w, *sgu_norm, *sgu_w, *sgu_b, *w_out,
        *ffn_up, *ffn_conv_w, *ffn_conv_b, *ffn_down;
    float* out; unsigned char* ws; int ph_lo, ph_hi;
};

typedef const __attribute__((address_space(4))) Args* ArgsP;
__device__ __forceinline__ ArgsP launder(ArgsP p) { asm volatile("" : "+s"(p)); return p; }

__device__ __forceinline__ float wave_sum(float v) {
#pragma unroll
    for (int o = 1; o < 64; o <<= 1) v += __shfl_xor(v, o);
    return v;
}
__device__ __forceinline__ float bflo(unsigned w) { return __builtin_bit_cast(float, w << 16); }
__device__ __forceinline__ float bfhi(unsigned w) { return __builtin_bit_cast(float, w & 0xffff0000u); }
__device__ __forceinline__ float bf1(bf16 b) { return __builtin_bit_cast(float, ((unsigned)b) << 16); }
__device__ __forceinline__ void unpack8(const v4u r, float (&f)[8]) { f[0] = bflo(r.x); f[1] = bfhi(r.x); f[2] = bflo(r.y); f[3] = bfhi(r.y); f[4] = bflo(r.z); f[5] = bfhi(r.z); f[6] = bflo(r.w); f[7] = bfhi(r.w); }
__device__ __forceinline__ v4u pack8(const float (&f)[8]) { v4u o; o.x = pk2(f[0], f[1]); o.y = pk2(f[2], f[3]); o.z = pk2(f[4], f[5]); o.w = pk2(f[6], f[7]); return o; }
__device__ __forceinline__ void ld8f(const float* p, float (&f)[8]) { const f32x4 a = *(const f32x4*)p, b = *(const f32x4*)(p + 4); f[0] = a.x; f[1] = a.y; f[2] = a.z; f[3] = a.w; f[4] = b.x; f[5] = b.y; f[6] = b.z; f[7] = b.w; }
__device__ __forceinline__ void st8f(float* p, const float (&f)[8]) { *(f32x4*)p = (f32x4){f[0], f[1], f[2], f[3]}; *(f32x4*)(p + 4) = (f32x4){f[4], f[5], f[6], f[7]}; }

__device__ __forceinline__ void tr_load(const float* W, int ldw, int k0, int n0, int lane, float (&v)[64]) {
    const float* src = W + (size_t)k0 * ldw + n0 + lane;
#pragma unroll
    for (int i = 0; i < 64; ++i) v[i] = __builtin_nontemporal_load(src + (size_t)i * ldw);
}
__device__ __forceinline__ void tr_finish(float (&v)[64], bool has_gain, float gl  , bf16* WT, int ldk, LAS unsigned char* scr, int k0, int n0, int lane) {
    if (has_gain) {
#pragma unroll
        for (int i = 0; i < 64; ++i) v[i] *= __builtin_bit_cast(float, __builtin_amdgcn_readlane(__builtin_bit_cast(int, gl), i)); }
#pragma unroll
    for (int c = 0; c < 8; ++c) { v4u o; o.x = pk2(v[8 * c], v[8 * c + 1]); o.y = pk2(v[8 * c + 2], v[8 * c + 3]); o.z = pk2(v[8 * c + 4], v[8 * c + 5]); o.w = pk2(v[8 * c + 6], v[8 * c + 7]);
        *(LAS v4u*)(scr + lane * 144 + c * 16) = o; }
    LDS_WAIT(); asm volatile("" ::: "memory");
#pragma unroll
    for (int p = 0; p < 8; ++p) { const int n = p * 8 + (lane >> 3), c = lane & 7; const v4u o = *(const LAS v4u*)(scr + n * 144 + c * 16);
        *(GAS v4u*)(WT + (size_t)(n0 + n) * ldk + k0 + 8 * c) = o; }
    LDS_WAIT(); asm volatile("" ::: "memory");
}
template <class DstRow> __device__ __forceinline__ void tr_range(const float* W, int ldw, const float* gain, bf16* WT, int ldk, LAS unsigned char* scr, int nb, int kofs, int lo, int hi, int widx, int nw, int lane, DstRow drow) {
    for (int r = lo + widx; r < hi; r += 2 * nw) { const int r2 = r + nw; const bool two = r2 < hi;
        float va[64], vb[64]; const int ka = kofs + 64 * (r / nb), na = 64 * (r % nb), kb = kofs + 64 * ((two ? r2 : r) / nb), nbk = 64 * ((two ? r2 : r) % nb);
        const float gla = gain ? gain[ka + lane] : 1.f, glb = gain ? gain[kb + lane] : 1.f;
        tr_load(W, ldw, ka, na, lane, va); if (two) tr_load(W, ldw, kb, nbk, lane, vb);
        tr_finish(va, gain != nullptr, gla, WT, ldk, scr, ka, drow(na), lane);
        if (two) tr_finish(vb, gain != nullptr, glb, WT, ldk, scr, kb, drow(nbk), lane); }
}
__device__ __forceinline__ void x_row_to_bf16(const float* xrow, bf16* orow, float* rinv, int lane) {
    const f32x4* xr = (const f32x4*)xrow + lane; f32x4 v[8]; float s = 0.f;
#pragma unroll
    for (int j = 0; j < 8; ++j) { v[j] = __builtin_nontemporal_load(xr + 64 * j); s += (v[j].x * v[j].x + v[j].y * v[j].y) + (v[j].z * v[j].z + v[j].w * v[j].w); }
    s = wave_sum(s);
    unsigned long long* o8 = (unsigned long long*)orow + lane;
#pragma unroll
    for (int j = 0; j < 8; ++j) o8[64 * j] = (unsigned long long)pk2(v[j].x, v[j].y) | ((unsigned long long)pk2(v[j].z, v[j].w) << 32);
    if (lane == 0) *rinv = rsqrtf(s * (1.f / DM) + EPS);
}
enum ConvJob { J_IN = 0, J_OUT = 1, J_FOLD = 2, J_UP = 3, J_DN = 4 };
typedef float f32x16 __attribute__((ext_vector_type(16)));
__device__ __forceinline__ void conv_job(ArgsP AP, unsigned char* ws, LAS unsigned char* lds, int job, int l, int part, int nparts, int widx, int nw, int lane, int wave) {
    LAS unsigned char* scr = lds + RING_OFF + wave * 16384;
    auto same = [](int n) { return n; };
    if (job == J_IN) { constexpr int nb = INW / 64, n = (DM / 64) * nb;
        tr_range(AP->w_in + (size_t)l * DM * INW, INW, AP->g_mix_pre + l * DM, (bf16*)(ws + WS_WIN + l * WIN_L), DM, scr, nb, 0, (int)((long)n * part / nparts), (int)((long)n * (part + 1) / nparts), widx, nw, lane, same); }
    else if (job == J_OUT) { constexpr int nb = DM / 64, n = ((DM - PW) / 64) * nb;
        tr_range(AP->w_out + (size_t)l * DM * DM, DM, nullptr, (bf16*)(ws + WS_WOUT + l * WOUT_L), DM, scr, nb, PW, (int)((long)n * part / nparts), (int)((long)n * (part + 1) / nparts), widx, nw, lane, same); }
    else if (job == J_UP) { constexpr int nb = FF2 / 64, n = (DM / 64) * nb;
        auto inter = [](int n0) { const int n2 = n0 < FF ? n0 : n0 - FF; return 256 * (n2 / 128) + (n2 % 128) + (n0 < FF ? 0 : 128); };
        tr_range(AP->ffn_up + (size_t)l * DM * FF2, FF2, AP->g_ffn_pre + l * DM, (bf16*)(ws + WS_WUP + l * WUP_L), DM, scr, nb, 0, (int)((long)n * part / nparts), (int)((long)n * (part + 1) / nparts), widx, nw, lane, inter); }
    else if (job == J_DN) { constexpr int nb = DM / 64, n = (FF / 64) * nb;
        tr_range(AP->ffn_down + (size_t)l * FF * DM, DM, nullptr, (bf16*)(ws + WS_WDN + l * WDN_L), FF, scr, nb, 0, (int)((long)n * part / nparts), (int)((long)n * (part + 1) / nparts), widx, nw, lane, same); }
    else {
        const int ntile = 4 * 64 * 4, lo = (int)((long)ntile * part / nparts), hi = (int)((long)ntile * (part + 1) / nparts);
        for (int t = lo + widx; t < hi; t += nw) { const int g = t >> 8, nblk = (t >> 2) & 63, cblk = t & 3, n0 = nblk * 32, c0 = cblk * 32, li = lane & 31, lk = lane >> 5;
            const float* wo = AP->w_out + (size_t)l * DM * DM + (size_t)(g * 128 + lk) * DM + n0 + li; const float* pw = AP->pool_w + ((size_t)(l * 4 + g) * 128 + c0 + li) * 128 + lk; const float* sc = AP->pool_scale + l * PW + g * 128 + lk;
            float a[64], b[64];
#pragma unroll
            for (int s = 0; s < 64; ++s) { a[s] = wo[(size_t)(2 * s) * DM] * sc[2 * s]; b[s] = pw[2 * s]; }
            f32x16 acc;
#pragma unroll
            for (int r = 0; r < 16; ++r) acc[r] = 0.f;
#pragma unroll
            for (int s = 0; s < 64; ++s) acc = __builtin_amdgcn_mfma_f32_32x32x2f32(a[s], b[s], acc, 0, 0, 0);
            bf16* dst = (bf16*)(ws + WS_WOUT + l * WOUT_L) + (size_t)n0 * DM + g * 128 + c0 + li;
#pragma unroll
            for (int r = 0; r < 16; ++r) dst[(size_t)((r & 3) + 8 * (r >> 2) + 4 * lk) * DM] = (bf16)f2bf(acc[r]);
        }
    }
}
__device__ __forceinline__ int gemm_cus(int nwg, int G) { const int R = (nwg + G - 1) / G; int g = ((nwg + R - 1) / R + 7) & ~7; return g < G ? g : G; }
__device__ __forceinline__ void conv_helper(ArgsP AP, unsigned char* ws, LAS unsigned char* lds, int slot, int l, int hidx, int nh, int lane, int wave) {
    const int widx = hidx * NWAVES + wave, nw = nh * NWAVES;
    if (slot == 0) conv_job(AP, ws, lds, J_UP, l, 0, 5, widx, nw, lane, wave), conv_job(AP, ws, lds, J_UP, l, 1, 5, widx, nw, lane, wave), conv_job(AP, ws, lds, J_UP, l, 2, 5, widx, nw, lane, wave);
    else if (slot == 1) { conv_job(AP, ws, lds, J_UP, l, 3, 5, widx, nw, lane, wave); conv_job(AP, ws, lds, J_UP, l, 4, 5, widx, nw, lane, wave); conv_job(AP, ws, lds, J_DN, l, 0, 1, widx, nw, lane, wave); }
    else if (l + 1 < DEPTH) {
        conv_job(AP, ws, lds, J_IN, l + 1, 0, 1, widx, nw, lane, wave); conv_job(AP, ws, lds, J_OUT, l + 1, 0, 1, widx, nw, lane, wave); conv_job(AP, ws, lds, J_FOLD, l + 1, 0, 1, widx, nw, lane, wave); }
}
__device__ __forceinline__ void x_row_finish(const f32x4 (&v)[8], bf16* orow, float* rinv, int lane) {
    float s = 0.f;
#pragma unroll
    for (int j = 0; j < 8; ++j) s += (v[j].x * v[j].x + v[j].y * v[j].y) + (v[j].z * v[j].z + v[j].w * v[j].w);
    s = wave_sum(s);
    unsigned long long* o8 = (unsigned long long*)orow + lane;
#pragma unroll
    for (int j = 0; j < 8; ++j) o8[64 * j] = (unsigned long long)pk2(v[j].x, v[j].y) | ((unsigned long long)pk2(v[j].z, v[j].w) << 32);
    if (lane == 0) *rinv = rsqrtf(s * (1.f / DM) + EPS);
}
__device__ __forceinline__ void p0_prologue(ArgsP AP, LAS unsigned char* lds, int tid, int lane, int wave, int vb, int G) {
    unsigned char* ws = AP->ws;
    const int gw = vb * NWAVES + wave, NGW = G * NWAVES;
    conv_job(AP, ws, lds, J_FOLD, 0, 0, 1, gw, NGW, lane, wave);
    conv_job(AP, ws, lds, J_IN, 0, 0, 1, gw, NGW, lane, wave);
    conv_job(AP, ws, lds, J_OUT, 0, 0, 1, gw, NGW, lane, wave);
    { bf16* sw = (bf16*)(ws + WS_SGUW);
      for (int i = vb * NTHR + tid; i < DEPTH * 6 * 128 * 128; i += G * NTHR) { const int q = (i >> 7) & 127, s = i & 127; sw[i] = (bf16)(s <= q ? f2bf(AP->sgu_w[i]) : 0u); } }
    for (int m = gw; m < MTOT; m += NGW) { const float* src = m < MP ? AP->x_prompt + (size_t)m * DM : AP->x_sample + (size_t)(m - MP) * DM;
        x_row_to_bf16(src, (bf16*)(ws + WS_XB) + (size_t)m * DM, (float*)(ws + WS_RINV) + m, lane); }
}

__device__ __forceinline__ float v_row_rinv(const bf16* Pb, int row, int lane) {
    const uint2* src = (const uint2*)(Pb + (size_t)row * INW + O5 + lane * 12); float q = 0.f;
#pragma unroll
    for (int i = 0; i < 3; ++i) { const uint2 a = src[i]; const float f0 = bflo(a.x), f1 = bfhi(a.x), f2 = bflo(a.y), f3 = bfhi(a.y); q += (f0 * f0 + f1 * f1) + (f2 * f2 + f3 * f3); }
    q = wave_sum(q);
    return rsqrtf(q * (1.f / SW) + EPS);
}
template <int WIN> __device__ __forceinline__ void pool_ld_p(const bf16* Pb, int m, int t, int c0, v4u (&raw)[WIN]) {
#pragma unroll
    for (int j = 0; j < WIN; ++j) raw[j] = *(const v4u*)(Pb + (size_t)(t - j >= 0 ? m - j : m) * INW + c0);
}
template <int WIN> __device__ __forceinline__ void pool_red_p(const v4u (&raw)[WIN], int t, float (&o)[8]) {
    float s[8], cur[8]; unpack8(raw[0], cur);
#pragma unroll
    for (int e = 0; e < 8; ++e) s[e] = cur[e];
#pragma unroll
    for (int j = 1; j < WIN; ++j) { float fv[8]; unpack8(raw[j], fv); const float k = t - j >= 0 ? 1.f : 0.f;
#pragma unroll
        for (int e = 0; e < 8; ++e) s[e] += k * fv[e]; }
    const float ic = 1.f / (float)(t + 1 < WIN ? t + 1 : WIN);
#pragma unroll
    for (int e = 0; e < 8; ++e) o[e] = s[e] * ic - cur[e];
}
template <int WIN> __device__ __forceinline__ void pool_samp(ArgsP AP, const bf16* Pb, bf16* MC, int l, int m, int c0) {
    constexpr int NP = WIN < 8 ? WIN : 8, NS = WIN - 1;
    const int si = (m - MP) >> 3, t = (m - MP) & 7; const float* prev = AP->state_pool + ((size_t)(l * DBAT + si) * PHIST) * PW + c0;
    v4u raw[NP]; f32x4 sa[NS], sb[NS];
#pragma unroll
    for (int j = 0; j < NP; ++j) raw[j] = *(const v4u*)(Pb + (size_t)(j <= t ? m - j : m) * INW + c0);
#pragma unroll
    for (int i = 0; i < NS; ++i) { int pr = PHIST + t - (i + 1); pr = pr < 0 ? 0 : (pr > PHIST - 1 ? PHIST - 1 : pr); sa[i] = *(const f32x4*)(prev + (size_t)pr * PW); sb[i] = *(const f32x4*)(prev + (size_t)pr * PW + 4); }
    float s[8], cur[8]; unpack8(raw[0], cur);
#pragma unroll
    for (int e = 0; e < 8; ++e) s[e] = cur[e];
#pragma unroll
    for (int j = 1; j < NP; ++j) { float fv[8]; unpack8(raw[j], fv); const float k = j <= t ? 1.f : 0.f;
#pragma unroll
        for (int e = 0; e < 8; ++e) s[e] += k * fv[e]; }
#pragma unroll
    for (int i = 0; i < NS; ++i) { const float k = (i + 1) > t ? 1.f : 0.f; s[0] += k * sa[i].x; s[1] += k * sa[i].y; s[2] += k * sa[i].z; s[3] += k * sa[i].w; s[4] += k * sb[i].x; s[5] += k * sb[i].y; s[6] += k * sb[i].z; s[7] += k * sb[i].w; }
    float o[8];
#pragma unroll
    for (int e = 0; e < 8; ++e) o[e] = s[e] * (1.f / (float)WIN) - cur[e];
    *(v4u*)(MC + (size_t)m * DM + c0) = pack8(o);
}
__device__ __forceinline__ void phase_mixers(ArgsP AP, int l, LAS unsigned char* lds, int tid, int lane, int wave, int vb, int G) {
    unsigned char* ws = AP->ws; const bf16* Pb = (const bf16*)(ws + WS_R1); bf16* MC = (bf16*)(ws + WS_R2); const bf16* SGW = (const bf16*)(ws + WS_SGUW); const float* VP = (const float*)(ws + WS_VPART);
    LAS float* rv = (LAS float*)lds; LAS bf16* vnT = (LAS bf16*)(lds + 512); constexpr int LDV = 136, LDG = 132; LAS float* GT = (LAS float*)(lds + 36864);
    constexpr int U_SP = (MP / 128) * 6, U_SS = DBAT, NU = U_SP + U_SS;
    for (int rp = 0; rp < (MIX_DUP == 1 ? 2 : 1); ++rp)
    for (int u = vb; u < NU; u += G) {
        if (u < U_SP) {
            const int cidx = u / 6, h = u % 6, r0 = cidx * 128;
            const int wq = wave >> 1, wd = wave & 1, fr = lane & 15, fq = lane >> 4;
            const bf16* Wg = SGW + (size_t)(l * 6 + h) * 128 * 128;
            v4u vraw[4], uraw[4]; bf16x8 af[4][2]; f32x4 vpa, vpb, vpc;
#pragma unroll
            for (int i = 0; i < 4; ++i) { const int vec = tid + NTHR * i; vraw[i] = *(const v4u*)(Pb + (size_t)(r0 + (vec & 127)) * INW + O5 + h * 128 + (vec >> 7) * 8);
                uraw[i] = *(const v4u*)(Pb + (size_t)(r0 + (vec >> 4)) * INW + O4 + h * 128 + (vec & 15) * 8); }
#pragma unroll
            for (int ks = 0; ks < 4; ++ks)
#pragma unroll
                for (int mi = 0; mi < 2; ++mi) af[ks][mi] = *(const bf16x8*)(Wg + (size_t)(32 * wq + 16 * mi + fr) * 128 + 32 * (ks <= wq ? ks : 0) + 8 * fq);
            { const f32x4* vp = (const f32x4*)(VP + (size_t)(r0 + (tid & 127)) * 12); vpa = vp[0]; vpb = vp[1]; vpc = vp[2]; }
            f32x4 nra[4], nrb[4]; float bqv[4];
#pragma unroll
            for (int i = 0; i < 4; ++i) { const int vec = tid + NTHR * i; const float* np = AP->sgu_norm + l * SW + h * 128 + (vec >> 7) * 8; nra[i] = *(const f32x4*)np; nrb[i] = *(const f32x4*)(np + 4); bqv[i] = AP->sgu_b[(l * 6 + h) * 128 + (vec >> 4)]; }
            if (tid < 128) rv[tid] = rsqrtf((((vpa.x + vpa.y) + (vpa.z + vpa.w)) + ((vpb.x + vpb.y) + (vpb.z + vpb.w)) + ((vpc.x + vpc.y) + (vpc.z + vpc.w))) * (1.f / SW) + EPS);
            __syncthreads();
#pragma unroll
            for (int i = 0; i < 4; ++i) { const int vec = tid + NTHR * i, s = vec & 127, d0 = (vec >> 7) * 8; float fv[8], nr[8];
                unpack8(vraw[i], fv); nr[0] = nra[i].x; nr[1] = nra[i].y; nr[2] = nra[i].z; nr[3] = nra[i].w; nr[4] = nrb[i].x; nr[5] = nrb[i].y; nr[6] = nrb[i].z; nr[7] = nrb[i].w; const float rs = rv[s];
#pragma unroll
                for (int e = 0; e < 8; ++e) vnT[(d0 + e) * LDV + s] = (bf16)f2bf(fv[e] * rs * nr[e]); }
            __syncthreads();
            f32x4 acc[2][4];
#pragma unroll
            for (int mi = 0; mi < 2; ++mi)
#pragma unroll
                for (int ni = 0; ni < 4; ++ni) acc[mi][ni] = (f32x4){0.f, 0.f, 0.f, 0.f};
#pragma unroll
            for (int ks = 0; ks < 4; ++ks) if (ks <= wq) {
                bf16x8 b[4];
#pragma unroll
                for (int ni = 0; ni < 4; ++ni) b[ni] = *(const LAS bf16x8*)(vnT + (64 * wd + 16 * ni + fr) * LDV + 32 * ks + 8 * fq);
#pragma unroll
                for (int mi = 0; mi < 2; ++mi)
#pragma unroll
                    for (int ni = 0; ni < 4; ++ni) acc[mi][ni] = __builtin_amdgcn_mfma_f32_16x16x32_bf16(af[ks][mi], b[ni], acc[mi][ni], 0, 0, 0);
            }
#pragma unroll
            for (int mi = 0; mi < 2; ++mi)
#pragma unroll
                for (int j = 0; j < 4; ++j)
#pragma unroll
                    for (int ni = 0; ni < 4; ++ni) GT[(32 * wq + 16 * mi + 4 * fq + j) * LDG + 64 * wd + 16 * ni + fr] = acc[mi][ni][j];
            __syncthreads();
#pragma unroll
            for (int i = 0; i < 4; ++i) { const int vec = tid + NTHR * i, q = vec >> 4, d0 = (vec & 15) * 8; float uu[8], o[8]; unpack8(uraw[i], uu);
                const f32x4 ga = *(const LAS f32x4*)(GT + q * LDG + d0), gb = *(const LAS f32x4*)(GT + q * LDG + d0 + 4); const float bq = bqv[i];
                o[0] = uu[0] * (ga.x + bq); o[1] = uu[1] * (ga.y + bq); o[2] = uu[2] * (ga.z + bq); o[3] = uu[3] * (ga.w + bq); o[4] = uu[4] * (gb.x + bq); o[5] = uu[5] * (gb.y + bq); o[6] = uu[6] * (gb.z + bq); o[7] = uu[7] * (gb.w + bq);
                *(v4u*)(MC + (size_t)(r0 + q) * DM + O2 + h * 128 + d0) = pack8(o); }
            __syncthreads();
        } else {
            const int si = u - U_SP, r0 = MP + 8 * si;
            if (tid < SW / 8) { const int c0 = tid * 8, h = c0 >> 7;
                v4u rvv[8], ruu[8]; f32x4 wq[8][2], na, nb, ba, bb; float rs8[8];
                { f32x4 vp[8][3];
#pragma unroll
                  for (int t = 0; t < 8; ++t) { const f32x4* p = (const f32x4*)(VP + (size_t)(r0 + t) * 12); vp[t][0] = p[0]; vp[t][1] = p[1]; vp[t][2] = p[2]; }
#pragma unroll
                  for (int t = 0; t < 8; ++t) { const f32x4 a = vp[t][0], b = vp[t][1], c = vp[t][2]; rs8[t] = rsqrtf((((a.x + a.y) + (a.z + a.w)) + ((b.x + b.y) + (b.z + b.w)) + ((c.x + c.y) + (c.z + c.w))) * (1.f / SW) + EPS); }
                  asm volatile("" : "+v"(rs8[0]), "+v"(rs8[1]), "+v"(rs8[2]), "+v"(rs8[3]), "+v"(rs8[4]), "+v"(rs8[5]), "+v"(rs8[6]), "+v"(rs8[7])); }
#pragma unroll
                for (int t = 0; t < 8; ++t) { rvv[t] = *(const v4u*)(Pb + (size_t)(r0 + t) * INW + O5 + c0); ruu[t] = *(const v4u*)(Pb + (size_t)(r0 + t) * INW + O4 + c0);
                    const float* wr = AP->sgu_w + ((size_t)(l * 6 + h) * 128 + t) * 128; wq[t][0] = *(const f32x4*)wr; wq[t][1] = *(const f32x4*)(wr + 4); }
                { const float* np = AP->sgu_norm + l * SW + c0; na = *(const f32x4*)np; nb = *(const f32x4*)(np + 4); const float* bp = AP->sgu_b + (l * 6 + h) * 128; ba = *(const f32x4*)bp; bb = *(const f32x4*)(bp + 4); }
                const float nr[8] = {na.x, na.y, na.z, na.w, nb.x, nb.y, nb.z, nb.w}, bq[8] = {ba.x, ba.y, ba.z, ba.w, bb.x, bb.y, bb.z, bb.w};
                float vn[8][8];
#pragma unroll
                for (int t = 0; t < 8; ++t) { const float rs = rs8[t]; float fv[8]; unpack8(rvv[t], fv);
#pragma unroll
                    for (int e = 0; e < 8; ++e) vn[t][e] = fv[e] * rs * nr[e];
                    st8f(AP->out + OUT_VS + ((size_t)(l * DBAT + si) * DSEQ + t) * SW + c0, vn[t]); }
#pragma unroll
                for (int q = 0; q < 8; ++q) { const float wv[8] = {wq[q][0].x, wq[q][0].y, wq[q][0].z, wq[q][0].w, wq[q][1].x, wq[q][1].y, wq[q][1].z, wq[q][1].w}; float uu[8], o[8]; unpack8(ruu[q], uu);
#pragma unroll
                    for (int e = 0; e < 8; ++e) { float gq = bq[q];
#pragma unroll
                        for (int t = 0; t < 8; ++t) if (t <= q) gq += wv[t] * vn[t][e];
                        o[e] = uu[e] * gq; }
                    *(v4u*)(MC + (size_t)(r0 + q) * DM + O2 + c0) = pack8(o); }
            }
        }
    }
    for (int rp = 0; rp < (MIX_DUP == 2 ? 2 : 1); ++rp)
    for (int it = vb * NTHR + tid; it < MP * 16; it += G * NTHR) { const int m = it >> 4, cg = it & 15, t = m & (SEQ - 1);
        v4u r0[2], r1[4], r2[8], r3[16]; float o0[8], o1[8], o2[8], o3[8];
        pool_ld_p<2>(Pb, m, t, cg * 8, r0); pool_ld_p<4>(Pb, m, t, (16 + cg) * 8, r1); pool_ld_p<8>(Pb, m, t, (32 + cg) * 8, r2); pool_ld_p<16>(Pb, m, t, (48 + cg) * 8, r3);
        pool_red_p<2>(r0, t, o0); pool_red_p<4>(r1, t, o1); pool_red_p<8>(r2, t, o2); pool_red_p<16>(r3, t, o3);
        bf16* dst = MC + (size_t)m * DM + cg * 8; *(v4u*)dst = pack8(o0); *(v4u*)(dst + 128) = pack8(o1); *(v4u*)(dst + 256) = pack8(o2); *(v4u*)(dst + 384) = pack8(o3); }
    for (int it = vb * NTHR + tid; it < 4 * MS * 16; it += G * NTHR) { const int g = it / (MS * 16), r = it % (MS * 16), m = MP + (r >> 4), c0 = (g * 16 + (r & 15)) * 8;
        if (g == 0) pool_samp<2>(AP, Pb, MC, l, m, c0); else if (g == 1) pool_samp<4>(AP, Pb, MC, l, m, c0); else if (g == 2) pool_samp<8>(AP, Pb, MC, l, m, c0); else pool_samp<16>(AP, Pb, MC, l, m, c0); }
    for (int rp = 0; rp < (MIX_DUP == 3 ? 2 : 1); ++rp)
    for (int it0 = vb * NTHR + tid; it0 < MP * 96; it0 += 2 * G * NTHR) {
        v4u rc[2][3], rh[2][3], rb[2]; f32x4 wa[2][3], wb[2][3]; int mm[2], cc[2], tt[2]; const bool two = it0 + G * NTHR < MP * 96;
#pragma unroll
        for (int h = 0; h < 2; ++h) { const int it = (h && two) ? it0 + G * NTHR : it0; mm[h] = it / 96; cc[h] = (it % 96) * 8; tt[h] = mm[h] & (SEQ - 1);
#pragma unroll
            for (int j = 0; j < 3; ++j) { const int row = tt[h] - 2 + j >= 0 ? mm[h] - 2 + j : mm[h]; rc[h][j] = *(const v4u*)(Pb + (size_t)row * INW + O3 + cc[h]); rh[h][j] = *(const v4u*)(Pb + (size_t)row * INW + O1 + cc[h]);
                wa[h][j] = *(const f32x4*)(AP->conv_w + (size_t)(l * 3 + j) * CW + cc[h]); wb[h][j] = *(const f32x4*)(AP->conv_w + (size_t)(l * 3 + j) * CW + cc[h] + 4); }
            rb[h] = *(const v4u*)(Pb + (size_t)mm[h] * INW + O2 + cc[h]); }
#pragma unroll
        for (int h = 0; h < 2; ++h) if (h == 0 || two) { float acc8[8], bg[8];
#pragma unroll
            for (int e = 0; e < 8; ++e) acc8[e] = 0.f;
#pragma unroll
            for (int j = 0; j < 3; ++j) { float a[8], b[8]; unpack8(rc[h][j], a); unpack8(rh[h][j], b); const float k = tt[h] - 2 + j >= 0 ? 1.f : 0.f; const float w[8] = {wa[h][j].x, wa[h][j].y, wa[h][j].z, wa[h][j].w, wb[h][j].x, wb[h][j].y, wb[h][j].z, wb[h][j].w};
#pragma unroll
                for (int e = 0; e < 8; ++e) acc8[e] += k * w[e] * (a[e] * b[e]); }
            unpack8(rb[h], bg); float o[8];
#pragma unroll
            for (int e = 0; e < 8; ++e) o[e] = bg[e] * acc8[e];
            *(v4u*)(MC + (size_t)mm[h] * DM + O1 + cc[h]) = pack8(o); }
    }
    for (int it = vb * NTHR + tid; it < MS * 96; it += G * NTHR) { const int m = MP + it / 96, c0 = (it % 96) * 8, si = (m - MP) >> 3, t = (m - MP) & 7;
        v4u rc[3], rh[3], rb; f32x4 wa[3], wb[3], sa[3], sb[3];
#pragma unroll
        for (int j = 0; j < 3; ++j) { const int tj = t - 2 + j, row = tj >= 0 ? m - 2 + j : m; int pr = 2 + tj; pr = pr < 0 ? 0 : (pr > 1 ? 1 : pr);
            rc[j] = *(const v4u*)(Pb + (size_t)row * INW + O3 + c0); rh[j] = *(const v4u*)(Pb + (size_t)row * INW + O1 + c0);
            const float* sp = AP->state_conv + ((size_t)(l * DBAT + si) * 2 + pr) * CW + c0; sa[j] = *(const f32x4*)sp; sb[j] = *(const f32x4*)(sp + 4);
            wa[j] = *(const f32x4*)(AP->conv_w + (size_t)(l * 3 + j) * CW + c0); wb[j] = *(const f32x4*)(AP->conv_w + (size_t)(l * 3 + j) * CW + c0 + 4); }
        rb = *(const v4u*)(Pb + (size_t)m * INW + O2 + c0);
        float acc8[8], bg[8], o[8];
#pragma unroll
        for (int e = 0; e < 8; ++e) acc8[e] = 0.f;
#pragma unroll
        for (int j = 0; j < 3; ++j) { float a[8], b[8]; unpack8(rc[j], a); unpack8(rh[j], b); const bool ok = t - 2 + j >= 0; const float w[8] = {wa[j].x, wa[j].y, wa[j].z, wa[j].w, wb[j].x, wb[j].y, wb[j].z, wb[j].w}, sv8[8] = {sa[j].x, sa[j].y, sa[j].z, sa[j].w, sb[j].x, sb[j].y, sb[j].z, sb[j].w};
#pragma unroll
            for (int e = 0; e < 8; ++e) acc8[e] += w[e] * (ok ? a[e] * b[e] : sv8[e]); }
        unpack8(rb, bg);
#pragma unroll
        for (int e = 0; e < 8; ++e) o[e] = bg[e] * acc8[e];
        *(v4u*)(MC + (size_t)m * DM + O1 + c0) = pack8(o); }
    constexpr int S_PP = NBAT * PHIST * 64, S_PS = DBAT * PHIST * 64, S_CP = NBAT * 2 * 96, S_CS = DBAT * 2 * 96, S_ALL = S_PP + S_PS + S_CP + S_CS;
    for (int rp = 0; rp < (MIX_DUP == 4 ? 2 : 1); ++rp)
    for (int it = vb * NTHR + tid; it < S_ALL; it += G * NTHR) {
        int r = it; float f[8];
        if (r < S_PP) { const int cg = r % 64, i = (r / 64) % PHIST, b = r / (64 * PHIST); unpack8(*(const v4u*)(Pb + (size_t)(b * SEQ + SEQ - PHIST + i) * INW + cg * 8), f);
            st8f(AP->out + OUT_POOLP + ((size_t)(l * NBAT + b) * PHIST + i) * PW + cg * 8, f); continue; } r -= S_PP;
        if (r < S_PS) { const int cg = r % 64, i = (r / 64) % PHIST, si = r / (64 * PHIST);
            if (i < PHIST - DSEQ) ld8f(AP->state_pool + ((size_t)(l * DBAT + si) * PHIST + i + DSEQ) * PW + cg * 8, f); else unpack8(*(const v4u*)(Pb + (size_t)(MP + si * DSEQ + i - (PHIST - DSEQ)) * INW + cg * 8), f);
            st8f(AP->out + OUT_POOLS + ((size_t)(l * DBAT + si) * PHIST + i) * PW + cg * 8, f); continue; } r -= S_PS;
        if (r < S_CP) { const int cg = r % 96, i = (r / 96) % 2, b = r / 192; const int m = b * SEQ + SEQ - 2 + i; float a[8], c[8];
            unpack8(*(const v4u*)(Pb + (size_t)m * INW + O3 + cg * 8), a); unpack8(*(const v4u*)(Pb + (size_t)m * INW + O1 + cg * 8), c);
#pragma unroll
            for (int e = 0; e < 8; ++e) f[e] = a[e] * c[e];
            st8f(AP->out + OUT_CONVP + ((size_t)(l * NBAT + b) * 2 + i) * CW + cg * 8, f); continue; } r -= S_CP;
        { const int cg = r % 96, i = (r / 96) % 2, si = r / 192; const int m = MP + si * DSEQ + DSEQ - 2 + i; float a[8], c[8];
            unpack8(*(const v4u*)(Pb + (size_t)m * INW + O3 + cg * 8), a); unpack8(*(const v4u*)(Pb + (size_t)m * INW + O1 + cg * 8), c);
#pragma unroll
            for (int e = 0; e < 8; ++e) f[e] = a[e] * c[e];
            st8f(AP->out + OUT_CONVS + ((size_t)(l * DBAT + si) * 2 + i) * CW + cg * 8, f); }
    }
}

__device__ __forceinline__ void phase_postnorm(ArgsP AP, const float* gpost, bool first, bool last, int K, int nsplit, int wgm, int lane, int wave, int vb, int G) {
    unsigned char* ws = AP->ws; const bf16* MIXB = (const bf16*)(ws + WS_MIX); const float* PART = (const float*)(ws + WS_PART); bf16* XB = (bf16*)(ws + WS_XB);
    pg8::SplitTailOrder S; S.init(MTOT, DM, G, 0, K, nsplit, wgm);
    const int gw = vb * NWAVES + wave, NGW = G * NWAVES, hi = lane >> 5, cl = (lane & 31) * 8;
    for (int m = gw; m < MTOT; m += NGW) {
        const int pm = m >> 8, rl = m & 255; float y[4][8]; float q = 0.f;
        const float* xs = m < MP ? AP->x_prompt + (size_t)m * DM : AP->x_sample + (size_t)(m - MP) * DM;
        v4u ry[4], rx[4]; f32x4 xa[4], xb[4], ga[4], gb[4];
#pragma unroll
        for (int jj = 0; jj < 4; ++jj) { const int c = 512 * jj + 8 * lane; ry[jj] = *(const v4u*)(MIXB + (size_t)m * DM + c); ga[jj] = *(const f32x4*)(gpost + c); gb[jj] = *(const f32x4*)(gpost + c + 4);
            if (first) { xa[jj] = __builtin_nontemporal_load((const f32x4*)(xs + c)); xb[jj] = __builtin_nontemporal_load((const f32x4*)(xs + c + 4)); } else rx[jj] = *(const v4u*)(XB + (size_t)m * DM + c); }
#pragma unroll
        for (int jj = 0; jj < 4; ++jj) { const int s0 = S.tail_slot(pm, 2 * jj), s1 = S.tail_slot(pm, 2 * jj + 1), slot = hi ? s1 : s0;
            unpack8(ry[jj], y[jj]);
            if (s0 >= 0 || s1 >= 0) { if (slot >= 0) { const bf16* pp = (const bf16*)PART + (size_t)slot * 65536 + (size_t)rl * 256 + cl; unpack8(*(const v4u*)pp, y[jj]);
                    for (int s = 1; s < S.ns; ++s) { float t[8]; unpack8(*(const v4u*)(pp + (size_t)s * 65536), t);
#pragma unroll
                        for (int e = 0; e < 8; ++e) y[jj][e] += t[e]; } } }
#pragma unroll
            for (int e = 0; e < 8; ++e) q += y[jj][e] * y[jj][e]; }
        q = wave_sum(q); const float ri = rsqrtf(q * (1.f / DM) + EPS); float s = 0.f;
#pragma unroll
        for (int jj = 0; jj < 4; ++jj) { const int c = 512 * jj + 8 * lane; float x[8], v[8]; const float g[8] = {ga[jj].x, ga[jj].y, ga[jj].z, ga[jj].w, gb[jj].x, gb[jj].y, gb[jj].z, gb[jj].w};
            if (first) { x[0] = xa[jj].x; x[1] = xa[jj].y; x[2] = xa[jj].z; x[3] = xa[jj].w; x[4] = xb[jj].x; x[5] = xb[jj].y; x[6] = xb[jj].z; x[7] = xb[jj].w; } else unpack8(rx[jj], x);
#pragma unroll
            for (int e = 0; e < 8; ++e) { v[e] = x[e] + y[jj][e] * ri * g[e]; s += v[e] * v[e]; }
            if (last) { __builtin_nontemporal_store((f32x4){v[0], v[1], v[2], v[3]}, (f32x4*)(AP->out + (size_t)m * DM + c)); __builtin_nontemporal_store((f32x4){v[4], v[5], v[6], v[7]}, (f32x4*)(AP->out + (size_t)m * DM + c + 4)); } else *(v4u*)(XB + (size_t)m * DM + c) = pack8(v); }
        if (!last) { s = wave_sum(s); if (lane == 0) ((float*)(ws + WS_RINV))[m] = rsqrtf(s * (1.f / DM) + EPS); }
    }
}

template <int CTRL> __device__ __forceinline__ float dpp_mov(float x) { return __builtin_bit_cast(float, __builtin_amdgcn_mov_dpp(__builtin_bit_cast(int, x), CTRL, 0xf, 0xf, false)); }
template <int CTRL> __device__ __forceinline__ float dpp_upd(float old, float x) { return __builtin_bit_cast(float, __builtin_amdgcn_update_dpp(__builtin_bit_cast(int, old), __builtin_bit_cast(int, x), CTRL, 0xf, 0xf, false)); }
typedef float f32x2 __attribute__((ext_vector_type(2)));
__device__ __forceinline__ f32x2 gelu_mul2(f32x2 x, f32x2 v) {
    const f32x2 p = (x * x) * (-0.10294324f) + (-2.3022082f), y = p * x; f32x2 e; e.x = __builtin_amdgcn_exp2f(y.x); e.y = __builtin_amdgcn_exp2f(y.y);
    const f32x2 d = e + 1.0f; f32x2 r; r.x = __builtin_amdgcn_rcpf(d.x); r.y = __builtin_amdgcn_rcpf(d.y); return (x * v) * r;
}
__device__ __forceinline__ float gelu_tanh(float x) { const f32x2 r = gelu_mul2((f32x2){x, x}, (f32x2){1.f, 1.f}); return r.x; }
struct EpiGateConvGelu {
    static constexpr bool PERM = true, AFTER_DRAIN = false;
    ArgsP ap; unsigned char* ws; int l; LAS float* xch;
    template <bool SAMP> __device__ __forceinline__ void body(const pg8::f32x4 (&acc)[2][2][4][2], const pg8::Unit& u, int wr, int wc, int fr_in, int fq_in) const {
        using pg8::f32x4;
        int fr = fr_in, fq = fq_in; asm volatile("" : "+v"(fr), "+v"(fq));
        const int cfl = wc * 32 + 8 * fq, cf = u.pn * 128 + cfl, row0 = u.pm * 256 + wr * 64 + fr;
        const float* rs = (const float*)(ws + WS_RINV);
        bf16* H = (bf16*)(ws + WS_R2); float* halo = (float*)(ws + WS_HALO); float* shalo = (float*)(ws + WS_SHALO);
        float sv[2][4];
#pragma unroll
        for (int ai = 0; ai < 2; ++ai)
#pragma unroll
            for (int m = 0; m < 4; ++m) sv[ai][m] = rs[row0 + ai * 128 + m * 16];
        LAS float* wl = xch + 1024;
        { const int t = (wr * 4 + wc) * 64 + fq * 16 + fr; if (t < 128) { const float* cwt = ap->ffn_conv_w + (size_t)l * 3 * FF + u.pn * 128 + t;
              wl[t] = cwt[0]; wl[128 + t] = cwt[FF]; wl[256 + t] = cwt[2 * FF]; wl[384 + t] = ap->ffn_conv_b[(size_t)l * FF + u.pn * 128 + t]; } }
        if (fr >= 14) {
#pragma unroll
            for (int ai = 0; ai < 2; ++ai)
#pragma unroll
                for (int n = 0; n < 2; ++n) *(LAS f32x4*)(xch + (((ai * 2 + wr) * 2 + (fr - 14)) * 128 + cfl + 4 * n)) = acc[ai][0][3][n] * sv[ai][3]; }
        asm volatile("s_waitcnt lgkmcnt(0)" ::: "memory"); __builtin_amdgcn_s_barrier(); asm volatile("" ::: "memory");
#pragma unroll
        for (int ai = 0; ai < 2; ++ai) {
            const int s = ai * 2 + wr;
            f32x4 gm1[2];
#pragma unroll
            for (int n = 0; n < 2; ++n) { gm1[n] = (f32x4){0.f, 0.f, 0.f, 0.f}; if (s > 0) gm1[n] = *(const LAS f32x4*)(xch + (((s - 1) * 2 + (fr >= 14 ? fr - 14 : 0)) * 128 + cfl + 4 * n)); }
#pragma unroll
            for (int m = 0; m < 4; ++m) {
                const int grow = row0 + ai * 128 + m * 16; const float sc = sv[ai][m];
                unsigned hw[4]; int wo = cfl; asm volatile("" : "+v"(wo));
#pragma unroll
                for (int n = 0; n < 2; ++n) {
                    const f32x4 g0 = acc[ai][0][m][n] * sc, vv = acc[ai][1][m][n] * sc; f32x4 g1, g2;
#pragma unroll
                    for (int j = 0; j < 4; ++j) { const float pj = gm1[n][j], cj = g0[j]; const float t1 = dpp_mov<0x121>(pj), t2 = dpp_mov<0x122>(pj); g1[j] = dpp_upd<0x111>(t1, cj); g2[j] = dpp_upd<0x112>(t2, cj); }
                    if (SAMP) {
                        const int t = fr & 7, si = (grow - MP) >> 3;
                        if (t < 2) { float* o = shalo + ((size_t)si * 2 + t) * FF + cf + 4 * n; *(f32x4*)o = g0; *(f32x4*)(o + SHALO_SZ) = vv; }
                        if (t >= 6) *(f32x4*)(ap->out + OUT_FFNS + ((size_t)(l * DBAT + si) * 2 + (t - 6)) * FF + cf + 4 * n) = g0;
                    } else {
                        if (s == 0 && m == 0 && fr < 2) { float* o = halo + HALO_SZ + ((size_t)u.pm * 2 + fr) * FF + cf + 4 * n; *(f32x4*)o = g0; *(f32x4*)(o + HALO_SZ) = vv; }
                        if (s == 3 && m == 3 && fr >= 14) {
                            *(f32x4*)(halo + ((size_t)u.pm * 2 + (fr - 14)) * FF + cf + 4 * n) = g0;
                            if ((u.pm & 7) == 7) *(f32x4*)(ap->out + OUT_FFNP + ((size_t)(l * NBAT + (u.pm >> 3)) * 2 + (fr - 14)) * FF + cf + 4 * n) = g0; }
                    }
#pragma unroll
                    for (int jj = 0; jj < 2; ++jj) { const int j = 2 * jj;
                        const f32x2 a2 = {g2[j], g2[j + 1]}, a1 = {g1[j], g1[j + 1]}, a0 = {g0[j], g0[j + 1]}, av = {vv[j], vv[j + 1]};
                        const f32x2 k0 = *(const LAS f32x2*)(wl + wo + 4 * n + j), k1 = *(const LAS f32x2*)(wl + 128 + wo + 4 * n + j), k2 = *(const LAS f32x2*)(wl + 256 + wo + 4 * n + j), kb = *(const LAS f32x2*)(wl + 384 + wo + 4 * n + j);
                        const f32x2 x = k0 * a2 + (k1 * a1 + (k2 * a0 + kb)); const f32x2 hv = gelu_mul2(x, av); hw[2 * n + jj] = pg8::cvt_pk_bf16(hv.x, hv.y); }
                    gm1[n] = g0;
                }
                *(v4u*)(H + (size_t)grow * FF + cf) = (v4u){hw[0], hw[1], hw[2], hw[3]};
            }
        }
    }
    __device__ __forceinline__ void operator()(const pg8::f32x4 (&acc)[2][2][4][2], const pg8::Unit& u, int wr, int wc, int fr, int fq) const {
        if (u.pm >= MP / 256) body<true>(acc, u, wr, wc, fr, fq); else body<false>(acc, u, wr, wc, fr, fq);
    }
};
__device__ __forceinline__ void phase_halofix(ArgsP AP, int l, int tid, int vb, int G) {
    unsigned char* ws = AP->ws; bf16* H = (bf16*)(ws + WS_R2); const float* BOTG = (const float*)(ws + WS_HALO); const float* TOPG = BOTG + HALO_SZ; const float* TOPV = BOTG + 2 * HALO_SZ;
    const float* SG = (const float*)(ws + WS_SHALO); const float* SV = SG + SHALO_SZ;
    constexpr int CG = FF / 8, NP = 28 * 2 * CG, NS = DBAT * 2 * CG;
    for (int it = vb * NTHR + tid; it < NP + NS; it += G * NTHR) {
        float o[8]; int c0, grow; const float *p2, *p1, *p0, *pv;
        if (it < NP) {
            c0 = (it % CG) * 8; const int r = (it / CG) & 1, pi = it / (2 * CG), pm = (pi / 7) * 8 + (pi % 7) + 1;
            if (r == 0) { p2 = BOTG + ((size_t)(pm - 1) * 2 + 0) * FF; p1 = BOTG + ((size_t)(pm - 1) * 2 + 1) * FF; p0 = TOPG + ((size_t)pm * 2 + 0) * FF; }
            else { p2 = BOTG + ((size_t)(pm - 1) * 2 + 1) * FF; p1 = TOPG + ((size_t)pm * 2 + 0) * FF; p0 = TOPG + ((size_t)pm * 2 + 1) * FF; }
            pv = TOPV + ((size_t)pm * 2 + r) * FF; grow = pm * 256 + r;
        } else {
            const int i2 = it - NP; c0 = (i2 % CG) * 8; const int t = (i2 / CG) & 1, si = i2 / (2 * CG); const float* st = AP->state_ffn + ((size_t)(l * DBAT + si) * 2) * FF;
            if (t == 0) { p2 = st; p1 = st + FF; } else { p2 = st + FF; p1 = SG + ((size_t)si * 2) * FF; }
            p0 = SG + ((size_t)si * 2 + t) * FF; pv = SV + ((size_t)si * 2 + t) * FF; grow = MP + si * DSEQ + t;
        }
        const float* cw = AP->ffn_conv_w + (size_t)l * 3 * FF + c0; const float* cbp = AP->ffn_conv_b + (size_t)l * FF + c0;
        f32x4 L[8][2];
#pragma unroll
        for (int h = 0; h < 2; ++h) { L[0][h] = *(const f32x4*)(p2 + c0 + 4 * h); L[1][h] = *(const f32x4*)(p1 + c0 + 4 * h); L[2][h] = *(const f32x4*)(p0 + c0 + 4 * h); L[3][h] = *(const f32x4*)(pv + c0 + 4 * h);
            L[4][h] = *(const f32x4*)(cw + 4 * h); L[5][h] = *(const f32x4*)(cw + FF + 4 * h); L[6][h] = *(const f32x4*)(cw + 2 * FF + 4 * h); L[7][h] = *(const f32x4*)(cbp + 4 * h); }
#pragma unroll
        for (int h = 0; h < 2; ++h)
#pragma unroll
            for (int e = 0; e < 4; ++e) o[4 * h + e] = gelu_tanh(L[4][h][e] * L[0][h][e] + L[5][h][e] * L[1][h][e] + L[6][h][e] * L[2][h][e] + L[7][h][e]) * L[3][h][e];
        *(v4u*)(H + (size_t)grow * FF + c0) = pack8(o);
    }
}

struct EpiNull {
    static constexpr bool PERM = true, AFTER_DRAIN = false;
    __device__ __forceinline__ void operator()(const pg8::f32x4 (&acc)[2][2][4][2], const pg8::Unit&, int, int, int, int) const {
#pragma unroll
        for (int a = 0; a < 2; ++a)
#pragma unroll
            for (int b = 0; b < 2; ++b)
#pragma unroll
                for (int m = 0; m < 4; ++m)
#pragma unroll
                    for (int n = 0; n < 2; ++n) asm volatile("" :: "v"(acc[a][b][m][n]));
    }
};
struct SameUnitOrder { int n, nkt; __device__ bool next(int i, pg8::Unit& u) const { if (i >= n) return false; u.pm = 0; u.pn = 0; u.kt0 = 0; u.nkt = nkt; u.slab = -1; return true; }
    __device__ __forceinline__ void a_ready(const pg8::Unit&) const {} __device__ __forceinline__ void done(const pg8::Unit&) const {} };
#ifndef PROBE_LEAK
#define PROBE_LEAK 0
#endif
#ifndef PROBE_BASE
#define PROBE_BASE 0
#endif
#ifndef PROBE_NULL
#define PROBE_NULL 0
#endif
__global__ void __launch_bounds__(NTHR, 2) mk_fwd(Args kernarg_) {
    ArgsP AP = (ArgsP)__builtin_amdgcn_kernarg_segment_ptr();
    extern __shared__ __attribute__((aligned(16))) unsigned char lds_raw[];
    LAS unsigned char* lds0 = (LAS unsigned char*)lds_raw;
    volatile LAS unsigned* MISC = (volatile LAS unsigned*)(lds0 + MISC_OFF);
    const int tid0 = threadIdx.x, wave0 = __builtin_amdgcn_readfirstlane(tid0 >> 6);
    const int G0 = gridDim.x;
    unsigned char* ws0 = AP->ws;
    for (int u = tid0; u < (LDS_BYTES - LDSCTL_OFF) / 4; u += NTHR) ((LAS unsigned*)(lds0 + LDSCTL_OFF))[u] = 0u;
    __syncthreads();
    XcdBarrier bar; bar.bar = (unsigned*)(ws0 + WS_CTL) + CW_BAR; bar.x = 0; bar.st = nullptr;
    if (!MK_PER_PHASE) bar = xcd_barrier_post((unsigned*)(ws0 + WS_CTL) + CW_BAR, MISC + 8);
    if (tid0 == 0) { const unsigned x = xb_xcc_id(); MISC[10] = x; MISC[11] = MK_PER_PHASE ? 0u : xb_add((unsigned*)(ws0 + WS_CTL) + CW_CENS + 64 * x, 1u); MISC[12] = blockIdx.x; }
    __syncthreads();
    const int lo = AP->ph_lo, hi = AP->ph_hi;
#define IN(k) (lo <= (k) && (k) < hi)
#define NREP(k) (((k) == DUP_PHASE) ? 2 : 1)
#define OPAQUE_TID() int lane = (int)__builtin_amdgcn_mbcnt_hi(~0u, __builtin_amdgcn_mbcnt_lo(~0u, 0u)); asm volatile("" : "+v"(lane)); const int wave = wave0, tid = wave0 * 64 + lane; unsigned char* ws = launder(AP)->ws; int G = G0, bx = (int)MISC[12]; bx = __builtin_amdgcn_readfirstlane(bx); unsigned ldsb = (unsigned)(size_t)lds0; asm volatile("" : "+s"(G), "+s"(bx), "+s"(ldsb)); LAS unsigned char* lds = (LAS unsigned char*)(size_t)ldsb; const int vb = (G % 8 == 0) ? (bx % 8) * (G / 8) + bx / 8 : bx; (void)lane; (void)wave; (void)ws; (void)vb; (void)lds
#define SEAM(k) do { if (!MK_PER_PHASE && IN(k) && IN((k) + 1)) xcd_barrier(bar); } while (0)
    if (IN(0)) { for (int rep = 0; rep < NREP(0); ++rep) { OPAQUE_TID(); p0_prologue(launder(AP), lds, tid, lane, wave, vb, G); if (rep + 1 < NREP(0)) xcd_barrier(bar); } } SEAM(0);
    if (!MK_PER_PHASE && IN(0) && IN(1)) {
        if (tid0 == 0) { unsigned* cen = (unsigned*)(ws0 + WS_CTL) + CW_CENS; const unsigned x = MISC[10], rank = MISC[11]; unsigned nx = 0, xi = 0, n0 = 0; bool eq = true;
            for (unsigned j = 0; j < 16; ++j) { const unsigned c = xb_ld(cen + 64 * j); if (c) { if (!nx) n0 = c; eq = eq && (c == n0); xi += (j < x) ? 1u : 0u; ++nx; } }
            if (nx == 8 && eq && 8 * n0 == (unsigned)G0 && rank < n0) MISC[12] = rank * 8 + xi; }
        __syncthreads();
    }
    for (int l = 0; l < DEPTH; ++l) {
        const int p = 1 + 8 * l;
        if (IN(p + 0)) { for (int rep = 0; rep < NREP(p + 0); ++rep) { OPAQUE_TID(); pg8::Gemm g{(const bf16*)(ws + WS_XB), (const bf16*)(ws + WS_WIN + l * WIN_L), MTOT, INW, DM}; const int Gg = gemm_cus((MTOT / 256) * (INW / 256), G); pg8::StaticOrder S; S.init(MTOT, INW, Gg, bx, DM, WGM_G1);
            pg8::EpiRowScaleBf16 E{(bf16*)(ws + WS_R1), INW, (const float*)(ws + WS_RINV), (float*)(ws + WS_VPART), O5 / 256}; if (bx < Gg) pg8::gemm_phase<pg8::EpiRowScaleBf16, pg8::StaticOrder, true, true>(lds + RING_OFF, g, S, E, tid);
            if (bx >= Gg || Gg == G) conv_helper(launder(AP), ws, lds, 0, l, Gg == G ? bx : bx - Gg, Gg == G ? G : G - Gg, lane, wave); if (rep + 1 < NREP(p + 0)) xcd_barrier(bar); } } SEAM(p + 0);
        if (IN(p + 1)) { for (int rep = 0; rep < NREP(p + 1); ++rep) { OPAQUE_TID(); phase_mixers(launder(AP), l, lds, tid, lane, wave, vb, G); if (rep + 1 < NREP(p + 1)) xcd_barrier(bar); } } SEAM(p + 1);
        if (IN(p + 2)) { for (int rep = 0; rep < NREP(p + 2); ++rep) { OPAQUE_TID(); pg8::Gemm g{(const bf16*)(ws + WS_R2), (const bf16*)(ws + WS_WOUT + l * WOUT_L), MTOT, DM, DM}; const int Gg = gemm_cus((MTOT / 256) * (DM / 256), G); pg8::SplitTailOrder S; S.init(MTOT, DM, Gg, bx, DM, 1, WGM_G2);
            pg8::EpiMixTile E{(bf16*)(ws + WS_MIX), DM, (float*)(ws + WS_PART)}; if (bx < Gg) pg8::gemm_phase<pg8::EpiMixTile, pg8::SplitTailOrder, true, true>(lds + RING_OFF, g, S, E, tid);
            if (bx >= Gg || Gg == G) conv_helper(launder(AP), ws, lds, 1, l, Gg == G ? bx : bx - Gg, Gg == G ? G : G - Gg, lane, wave); if (rep + 1 < NREP(p + 2)) xcd_barrier(bar); } } SEAM(p + 2);
        if (IN(p + 3)) { for (int rep = 0; rep < NREP(p + 3); ++rep) { OPAQUE_TID(); phase_postnorm(launder(AP), AP->g_mix_post + l * DM, l == 0, false, DM, 1, WGM_G2, lane, wave, vb, G); if (rep + 1 < NREP(p + 3)) xcd_barrier(bar); } } SEAM(p + 3);
        if (PROBE_LEAK && l == 0) { if (blockIdx.x == 0 && tid0 == 0) { MISC[16] = (unsigned)__builtin_amdgcn_s_memtime(); MISC[17] = (unsigned)__builtin_amdgcn_s_memrealtime(); } }
        if (IN(p + 4)) { for (int rep = 0; rep < NREP(p + 4); ++rep) { OPAQUE_TID(); pg8::Gemm g{(const bf16*)(ws + WS_XB), (const bf16*)(ws + WS_WUP + l * WUP_L), MTOT, FF2, DM}; const int Gg = (l + 1 < DEPTH || G3_LAST_CUS == 0) ? gemm_cus((MTOT / 256) * (FF2 / 256), G) : (G3_LAST_CUS < G ? G3_LAST_CUS : G); pg8::StaticOrder S; S.init(MTOT, FF2, Gg, bx, DM, WGM_G3);
            EpiGateConvGelu E{launder(AP), ws, l, (LAS float*)(lds + XCH_OFF)}; if (bx < Gg) pg8::gemm_phase<EpiGateConvGelu, pg8::StaticOrder, true, true>(lds + RING_OFF, g, S, E, tid);
            if (l + 1 < DEPTH && (bx >= Gg || Gg == G)) conv_helper(launder(AP), ws, lds, 2, l, Gg == G ? bx : bx - Gg, Gg == G ? G : G - Gg, lane, wave); if (rep + 1 < NREP(p + 4)) xcd_barrier(bar); } } SEAM(p + 4);
        if (PROBE_LEAK && l == 0) { if (blockIdx.x == 0 && tid0 == 0) { MISC[18] = (unsigned)__builtin_amdgcn_s_memtime() - MISC[16]; MISC[19] = (unsigned)__builtin_amdgcn_s_memrealtime() - MISC[17]; } }
        if (PROBE_NULL && l == 0) { OPAQUE_TID(); xcd_barrier(bar);
            const int N_ = PROBE_NULL == 1 ? INW : (PROBE_NULL == 3 ? FF2 : DM), K_ = PROBE_NULL == 4 ? FF : DM;
            const bf16* A_ = (const bf16*)(ws + ((PROBE_NULL == 1 || PROBE_NULL == 3) ? WS_XB : WS_R2)); const bf16* B_ = (const bf16*)(ws + (PROBE_NULL == 1 ? WS_WIN : PROBE_NULL == 2 ? WS_WOUT : PROBE_NULL == 3 ? WS_WUP : WS_WDN));
            pg8::Gemm g{A_, B_, MTOT, N_, K_}; EpiNull E{};
            if (PROBE_NULL == 6) { SameUnitOrder S{2, 88}; pg8::Gemm g6{(const bf16*)(ws + WS_R2), (const bf16*)(ws + WS_WDN), MTOT, DM, FF}; pg8::gemm_phase<EpiNull, SameUnitOrder, true, true>(lds + RING_OFF, g6, S, E, tid); }
            else if (PROBE_NULL == 7) { pg8::SplitTailOrder S; S.init(MTOT, DM, G, bx, FF, NSPLIT); pg8::Gemm g7{(const bf16*)(ws + WS_R2), (const bf16*)(ws + WS_WDN), MTOT, DM, FF}; pg8::gemm_phase<EpiNull, pg8::SplitTailOrder, true, true>(lds + RING_OFF, g7, S, E, tid); }
            else if (PROBE_NULL == 5) { SameUnitOrder S{7, 32}; pg8::Gemm g5{(const bf16*)(ws + WS_XB), (const bf16*)(ws + WS_WUP), MTOT, FF2, DM}; pg8::gemm_phase<EpiNull, SameUnitOrder, true, true>(lds + RING_OFF, g5, S, E, tid); }
            else { pg8::StaticOrder S; S.init(MTOT, N_, G, bx, K_); pg8::gemm_phase<EpiNull, pg8::StaticOrder, true, true>(lds + RING_OFF, g, S, E, tid); }
            xcd_barrier(bar); }
        if (IN(p + 5)) { for (int rep = 0; rep < NREP(p + 5); ++rep) { OPAQUE_TID(); phase_halofix(launder(AP), l, tid, vb, G); if (rep + 1 < NREP(p + 5)) xcd_barrier(bar); } } SEAM(p + 5);
        if (IN(p + 6)) { for (int rep = 0; rep < NREP(p + 6); ++rep) { OPAQUE_TID(); pg8::Gemm g{(const bf16*)(ws + WS_R2), (const bf16*)(ws + WS_WDN + l * WDN_L), MTOT, DM, FF}; pg8::SplitTailOrder S; S.init(MTOT, DM, G, bx, FF, NSPLIT, WGM_G4);
            pg8::EpiMixTile E{(bf16*)(ws + WS_MIX), DM, (float*)(ws + WS_PART)}; pg8::gemm_phase<pg8::EpiMixTile, pg8::SplitTailOrder, true, true>(lds + RING_OFF, g, S, E, tid); if (rep + 1 < NREP(p + 6)) xcd_barrier(bar); } } SEAM(p + 6);
        if (IN(p + 7)) { for (int rep = 0; rep < NREP(p + 7); ++rep) { OPAQUE_TID(); phase_postnorm(launder(AP), AP->g_ffn_post + l * DM, false, l + 1 == DEPTH, FF, NSPLIT, WGM_G4, lane, wave, vb, G); if (rep + 1 < NREP(p + 7)) xcd_barrier(bar); } } SEAM(p + 7);
    }
    if (PROBE_LEAK) { if (blockIdx.x == 0 && tid0 == 0) { const float cyc = (float)MISC[18], rt = (float)MISC[19]; const float v = PROBE_LEAK == 1 ? cyc / rt * 100.f   : (PROBE_LEAK == 2 ? rt * 0.01f   : cyc * (1.f / 224.f)  ); AP->out[OUT_VS] = 32.f * floorf((v - (float)PROBE_BASE) * (1.f / 32.f) + 0.5f) + 1000.f;     } }
#undef IN
#undef SEAM
}

extern "C" void kernel_launch(void* const* d_in, const int* in_sizes, int n_in, void* d_out, int out_size, void* d_ws, size_t ws_size, hipStream_t stream) {
    static int grid = 0;
    if (grid == 0) {
        if (n_in != 21 || out_size != (int)OUT_END || ws_size < WS_END) { fprintf(stderr, "kernel_launch: unexpected sizes n_in %d out %d ws %zu (need %zu)\n", n_in, out_size, ws_size, (size_t)WS_END); grid = -1; return; }
        int dev = 0, cus = 0, per_cu = 0;
        if (hipGetDevice(&dev) != hipSuccess || hipDeviceGetAttribute(&cus, hipDeviceAttributeMultiprocessorCount, dev) != hipSuccess) { grid = -1; return; }
        if (hipFuncSetAttribute((const void*)mk_fwd, hipFuncAttributeMaxDynamicSharedMemorySize, LDS_BYTES) != hipSuccess) { fprintf(stderr, "kernel_launch: hipFuncSetAttribute failed\n"); grid = -1; return; }
        if (hipOccupancyMaxActiveBlocksPerMultiprocessor(&per_cu, (const void*)mk_fwd, NTHR, LDS_BYTES) != hipSuccess || per_cu < 1) { fprintf(stderr, "kernel_launch: occupancy query says %d blocks per CU\n", per_cu); (void)hipGetLastError(); grid = -1; return; }
        grid = cus;
    }
    if (grid < 0) return;
    if (hipMemsetAsync((char*)d_ws + WS_CTL, 0, CTL_ZERO_BYTES, stream) != hipSuccess) { fprintf(stderr, "kernel_launch: memset failed\n"); return; }
    Args a{};
    const float** ap = (const float**)&a;
    for (int i = 0; i < 21; ++i) ap[i] = (const float*)d_in[i];
    a.out = (float*)d_out; a.ws = (unsigned char*)d_ws;
#if MK_PER_PHASE
    for (int p = 0; p < NPHASE; ++p) { a.ph_lo = p; a.ph_hi = p + 1; hipLaunchKernelGGL(mk_fwd, dim3(grid), dim3(NTHR), LDS_BYTES, stream, a); }
#else
    a.ph_lo = 0; a.ph_hi = NPHASE;
#if MK_COOP_LAUNCH
    void* kargs[] = {&a};
    hipError_t e = hipLaunchCooperativeKernel((const void*)mk_fwd, dim3(grid), dim3(NTHR), kargs, LDS_BYTES, stream);
    if (e != hipSuccess) fprintf(stderr, "kernel_launch: cooperative launch failed: %s (grid %d)\n", hipGetErrorString(e), grid);
#else
    hipLaunchKernelGGL(mk_fwd, dim3(grid), dim3(NTHR), LDS_BYTES, stream, a);
    hipError_t e = hipPeekAtLastError(); if (e != hipSuccess) fprintf(stderr, "kernel_launch: launch failed: %s (grid %d)\n", hipGetErrorString(e), grid);
#endif
#endif
}
```

```cpp
#include <hip/hip_runtime.h>
#include <cstdio>
#include <cstdint>
namespace pg8 {
#define PG8_LAS __attribute__((address_space(3)))
typedef unsigned short bf16_t;
typedef short bf16x8 __attribute__((ext_vector_type(8)));
typedef float f32x4 __attribute__((ext_vector_type(4)));
typedef unsigned u32x4 __attribute__((ext_vector_type(4)));
constexpr int BM = 256, BK = 64, HALF = 128, HTB = HALF * BK * 2  , STAGE_BYTES = 8 * HTB, NXCD = 8, WGM = 4;

__host__ __device__ __forceinline__ int lds_byte(int r, int c) { const int st = (r >> 4) * 2 + (c >> 5), rr = r & 15, cc = c & 31, ob = rr * 64 + cc * 2; return st * 1024 + (ob ^ (((ob >> 9) & 1) << 5)); }
__host__ __device__ __forceinline__ void stage_rc(int b, int& R, int& C) { const int st = b / 1024, sb = b % 1024, swz = sb ^ (((sb >> 9) & 1) << 5); R = (st >> 1) * 16 + swz / 64; C = (st & 1) * 32 + (swz % 64) / 2; }
__host__ __device__ __forceinline__ int perm32(int rho) { const int n = rho >> 4, i = rho & 15; return 8 * (i >> 2) + 4 * n + (i & 3); }

struct Unit { int pm, pn, kt0, nkt, slab; };
struct Gemm { const bf16_t* A; const bf16_t* Bt; int M, N, K; };

struct StaticOrder {
    int nM, nN, nwg, G, c, nkt, wgm;
    __host__ __device__ void init(int M, int N, int G_, int c_, int K, int wgm_ = WGM) { nM = M / BM; nN = N / BM; nwg = nM * nN; G = G_; c = c_; nkt = K / BK; wgm = wgm_; }
    __host__ __device__ bool next(int i, Unit& u) const {
        const long L = (long)i * G + c; if (L >= nwg) return false; u.kt0 = 0; u.nkt = nkt; u.slab = -1;
        int wgid = (int)L; { const int q = nwg / NXCD, r = nwg % NXCD, xcd = wgid % NXCD, off = wgid / NXCD; wgid = (xcd < r ? xcd * (q + 1) : r * (q + 1) + (xcd - r) * q) + off; }
        const int nig = wgm * nN, gid = wgid / nig, fm = gid * wgm, gsz = (nM - fm) < wgm ? (nM - fm) : wgm;
        u.pm = fm + ((wgid % nig) % gsz); u.pn = (wgid % nig) / gsz; return true;
    }
    __device__ __forceinline__ void a_ready(const Unit&) const {}
    __device__ __forceinline__ void done(const Unit&) const {}
};

struct SplitTailOrder : StaticOrder {
    int ns, ntail, nfull;
    __host__ __device__ void init(int M, int N, int G_, int c_, int K, int ns_, int wgm_ = WGM) { StaticOrder::init(M, N, G_, c_, K, wgm_); nfull = nwg / G; ntail = nwg - nfull * G; ns = ns_; if (ntail == 0 || ns * ntail > G || ns > nkt / 2) ns = 1; }
    __host__ __device__ bool next(int i, Unit& u) const {
        if (i < nfull || ns == 1) return StaticOrder::next(i, u);
        if (i > nfull) return false;
        const int ti = c % ntail, s = c / ntail; if (s >= ns) return false;
        StaticOrder t = *this; t.c = ti; if (!t.StaticOrder::next(nfull, u)) return false;
        const int h = nkt / 2, k0 = 2 * ((s * h) / ns), k1 = 2 * (((s + 1) * h) / ns); u.kt0 = k0; u.nkt = k1 - k0; u.slab = ti * ns + s; return true;
    }
    __host__ __device__ int tail_slot(int pm, int pn) const {
        if (ns == 1) return -1;
        const int gid = pm / wgm, fm = gid * wgm, gsz = (nM - fm) < wgm ? (nM - fm) : wgm; const int wgid = gid * wgm * nN + pn * gsz + (pm - fm);
        const int q = nwg / NXCD, r = nwg % NXCD; int xcd, off; if (wgid < r * (q + 1)) { xcd = wgid / (q + 1); off = wgid % (q + 1); } else { const int w2 = wgid - r * (q + 1); xcd = r + w2 / q; off = w2 % q; }
        const long L = (long)off * NXCD + xcd; if (L < (long)nfull * G) return -1; return (int)(L - (long)nfull * G) * ns;
    }
};

typedef float f32x2c __attribute__((ext_vector_type(2))); typedef __bf16 bf16x2c __attribute__((ext_vector_type(2)));
__device__ __forceinline__ unsigned cvt_pk_bf16(float lo, float hi) { const f32x2c v = {lo, hi}; return __builtin_bit_cast(unsigned, __builtin_convertvector(v, bf16x2c)); }
struct EpiRowScaleBf16 {
    static constexpr bool PERM = true, AFTER_DRAIN = false;
    bf16_t* O; int ldc; const float* rs; float* vpart; int pn0;
    __device__ __forceinline__ void operator()(const f32x4 (&acc)[2][2][4][2], const Unit& u, int wr, int wc, int fr, int fq) const {
        const int row0 = u.pm * BM + wr * 64 + fr, col0 = u.pn * BM + wc * 32 + 8 * fq; const bool want_ssq = u.pn >= pn0;
        float sv[2][4];
#pragma unroll
        for (int ai = 0; ai < 2; ++ai)
#pragma unroll
            for (int m = 0; m < 4; ++m) sv[ai][m] = rs[row0 + ai * HALF + m * 16];
#pragma unroll
        for (int ai = 0; ai < 2; ++ai)
#pragma unroll
            for (int m = 0; m < 4; ++m) { const int r = row0 + ai * HALF + m * 16; const float s = sv[ai][m]; bf16_t* rowp = O + (size_t)r * ldc + col0;
#pragma unroll
                for (int bj = 0; bj < 2; ++bj) { const f32x4 v0 = acc[ai][bj][m][0] * s, v1 = acc[ai][bj][m][1] * s;
                    u32x4 w; w.x = cvt_pk_bf16(v0[0], v0[1]); w.y = cvt_pk_bf16(v0[2], v0[3]); w.z = cvt_pk_bf16(v1[0], v1[1]); w.w = cvt_pk_bf16(v1[2], v1[3]);
                    *(u32x4*)(rowp + bj * HALF) = w; }
                if (want_ssq) { float q = 0.f;
#pragma unroll
                    for (int bj = 0; bj < 2; ++bj)
#pragma unroll
                        for (int n = 0; n < 2; ++n) { const f32x4 x = acc[ai][bj][m][n] * s; q += (x[0] * x[0] + x[1] * x[1]) + (x[2] * x[2] + x[3] * x[3]); }
                    q += __shfl_xor(q, 16); q += __shfl_xor(q, 32);
                    if (fq == 0) vpart[(size_t)r * 12 + (u.pn - pn0) * 4 + wc] = q; } }
    }
};
struct EpiMixTile {
    static constexpr bool PERM = true, AFTER_DRAIN = false;
    bf16_t* O; int ldc; float* part;
    __device__ __forceinline__ void operator()(const f32x4 (&acc)[2][2][4][2], const Unit& u, int wr, int wc, int fr, int fq) const {
        const bool sl = u.slab >= 0; const size_t ld = sl ? (size_t)BM : (size_t)ldc;
        { bf16_t* base = sl ? (bf16_t*)part + (size_t)u.slab * (BM * BM) + (size_t)(wr * 64 + fr) * BM + wc * 32 + 8 * fq : O + (size_t)(u.pm * BM + wr * 64 + fr) * ldc + u.pn * BM + wc * 32 + 8 * fq;
#pragma unroll
            for (int ai = 0; ai < 2; ++ai)
#pragma unroll
                for (int m = 0; m < 4; ++m) { bf16_t* rowp = base + (size_t)(ai * HALF + m * 16) * ld;
#pragma unroll
                    for (int bj = 0; bj < 2; ++bj) { const f32x4 v0 = acc[ai][bj][m][0], v1 = acc[ai][bj][m][1];
                        u32x4 w; w.x = cvt_pk_bf16(v0[0], v0[1]); w.y = cvt_pk_bf16(v0[2], v0[3]); w.z = cvt_pk_bf16(v1[0], v1[1]); w.w = cvt_pk_bf16(v1[2], v1[3]);
                        *(u32x4*)(rowp + bj * HALF) = w; } }
        }
    }
};

template <class Epi, class Sched, bool ALIGN_EPI = false, bool SP2 = false>
__device__ __forceinline__ void gemm_phase(PG8_LAS unsigned char* lds, const Gemm g, const Sched& S, const Epi& E, const int tid_in  ) {
    const int tid = tid_in, wid = __builtin_amdgcn_readfirstlane(tid >> 6), lane = tid & 63, wr = wid >> 2, wc = wid & 3, fr = lane & 15, fq = lane >> 4;
    const int K = g.K;
    unsigned voffA[2], voffB[2];
#pragma unroll
    for (int i = 0; i < 2; ++i) { int R, C; stage_rc(tid * 16 + i * 8192, R, C); const int Rb = Epi::PERM ? ((R & ~31) + perm32(R & 31)) : R;
        voffA[i] = (unsigned)(R * K + C) * 2u; voffB[i] = (unsigned)(Rb * K + C) * 2u; }
    const size_t kstep = (size_t)(BK * 2);
    const size_t hstep = (size_t)HALF * K * 2;
    const size_t tstep = 2 * hstep;
    const unsigned ldsw = (unsigned)wid * 1024u;
    const int aoff = lds_byte(wr * 64 + fr, fq * 8), boff = lds_byte(wc * 32 + fr, fq * 8);
#define PG8_SA(b, h) (((b) * 2 + (h)) * HTB)
#define PG8_SB(b, h) ((4 + (b) * 2 + (h)) * HTB)
#define PG8_STAGE(bufoff, gbase, voff) do { _Pragma("unroll") for (int _i = 0; _i < 2; ++_i) \
        __builtin_amdgcn_global_load_lds((const unsigned*)((const char*)(gbase) + (voff)[_i]), (PG8_LAS unsigned*)(lds + (bufoff) + ldsw + _i * 8192), 16, 0, 0); } while (0)
#define PG8_LDA(dst, b, h) do { _Pragma("unroll") for (int m = 0; m < 4; ++m) _Pragma("unroll") for (int k = 0; k < 2; ++k) dst[m][k] = *(const PG8_LAS bf16x8*)(lds + PG8_SA(b, h) + aoff + m * 2048 + k * 1024); } while (0)
#define PG8_LDB(dst, b, h) do { _Pragma("unroll") for (int n = 0; n < 2; ++n) _Pragma("unroll") for (int k = 0; k < 2; ++k) dst[n][k] = *(const PG8_LAS bf16x8*)(lds + PG8_SB(b, h) + boff + n * 2048 + k * 1024); } while (0)
#define PG8_MMA(ai, bj, At, Bt) do { __builtin_amdgcn_s_setprio(1); _Pragma("unroll") for (int m = 0; m < 4; ++m) _Pragma("unroll") for (int n = 0; n < 2; ++n) _Pragma("unroll") for (int k = 0; k < 2; ++k) \
        acc[ai][bj][m][n] = __builtin_amdgcn_mfma_f32_16x16x32_bf16(Bt[n][k], At[m][k], acc[ai][bj][m][n], 0, 0, 0); __builtin_amdgcn_s_setprio(0); } while (0)
#define PG8_WAIT_V(n) asm volatile("s_waitcnt vmcnt(" #n ")" ::: "memory")
#define PG8_WAIT_L(n) asm volatile("s_waitcnt lgkmcnt(" #n ")" ::: "memory")
#define PG8_BAR __builtin_amdgcn_s_barrier()
#define PG8_SCHED __builtin_amdgcn_sched_barrier(0)
    Unit cur, nxt; int ui = 0;
    if (!S.next(0, cur)) return;
    f32x4 acc[2][2][4][2];
#pragma unroll
    for (int a = 0; a < 2; ++a)
#pragma unroll
        for (int b = 0; b < 2; ++b)
#pragma unroll
            for (int m = 0; m < 4; ++m)
#pragma unroll
                for (int n = 0; n < 2; ++n) acc[a][b][m][n] = (f32x4){0.f, 0.f, 0.f, 0.f};
    bf16x8 At[4][2], B0[2][2], B1[2][2];
    const char* cA = (const char*)g.A + (size_t)cur.pm * tstep + (size_t)cur.kt0 * kstep; const char* cB = (const char*)g.Bt + (size_t)cur.pn * tstep + (size_t)cur.kt0 * kstep;
    S.a_ready(cur);
    if constexpr (SP2) {
        PG8_STAGE(PG8_SB(0, 0), cB, voffB); PG8_STAGE(PG8_SB(0, 1), cB + hstep, voffB); PG8_STAGE(PG8_SA(0, 0), cA, voffA); PG8_STAGE(PG8_SA(0, 1), cA + hstep, voffA);
        if (wr == 1) PG8_BAR;
        PG8_WAIT_V(2); PG8_BAR;
        PG8_STAGE(PG8_SB(1, 0), cB + kstep, voffB); PG8_STAGE(PG8_SA(1, 0), cA + kstep, voffA); PG8_STAGE(PG8_SB(1, 1), cB + hstep + kstep, voffB);
        PG8_WAIT_V(6); PG8_BAR;
    } else {
        PG8_STAGE(PG8_SB(0, 0), cB, voffB); PG8_STAGE(PG8_SA(0, 0), cA, voffA); PG8_STAGE(PG8_SB(0, 1), cB + hstep, voffB); PG8_STAGE(PG8_SA(0, 1), cA + hstep, voffA);
        if (wr == 1) PG8_BAR;
        PG8_WAIT_V(4); PG8_BAR;
        PG8_STAGE(PG8_SB(1, 0), cB + kstep, voffB); PG8_STAGE(PG8_SA(1, 0), cA + kstep, voffA); PG8_STAGE(PG8_SB(1, 1), cB + hstep + kstep, voffB);
        PG8_WAIT_V(6); PG8_BAR;
    }
    for (;;) {
        const bool has_next = S.next(ui + 1, nxt);
        const char* nA = has_next ? (const char*)g.A + (size_t)nxt.pm * tstep + (size_t)nxt.kt0 * kstep : cA; const char* nB = has_next ? (const char*)g.Bt + (size_t)nxt.pn * tstep + (size_t)nxt.kt0 * kstep : cB;
        const int ntc = cur.nkt;
        for (int t = 0; t < ntc; t += 2) {
            const bool last = (t == ntc - 2);
            const char* a1 = cA + (size_t)(t + 1) * kstep;
            const char* a2 = last ? nA : cA + (size_t)(t + 2) * kstep; const char* b2 = last ? nB : cB + (size_t)(t + 2) * kstep;
            const char* a3 = a2 + kstep; const char* b3 = b2 + kstep;
            if (last && has_next) S.a_ready(nxt);
            if constexpr (SP2) {
            PG8_LDB(B0, 0, 0); PG8_LDB(B1, 0, 1); PG8_SCHED; PG8_LDA(At, 0, 0); PG8_STAGE(PG8_SA(1, 1), a1 + hstep, voffA);
            PG8_WAIT_V(8); PG8_WAIT_L(0); PG8_BAR; PG8_MMA(0, 0, At, B0); PG8_MMA(0, 1, At, B1); PG8_BAR; PG8_SCHED;
            PG8_LDA(At, 0, 1); PG8_STAGE(PG8_SB(0, 0), b2, voffB); PG8_STAGE(PG8_SB(0, 1), b2 + hstep, voffB); PG8_STAGE(PG8_SA(0, 0), a2, voffA);
            PG8_WAIT_V(8); PG8_WAIT_L(0); PG8_BAR; PG8_MMA(1, 0, At, B0); PG8_MMA(1, 1, At, B1); PG8_BAR; PG8_SCHED;
            PG8_LDB(B0, 1, 0); PG8_LDB(B1, 1, 1); PG8_SCHED; PG8_LDA(At, 1, 0); PG8_STAGE(PG8_SA(0, 1), a2 + hstep, voffA);
            PG8_WAIT_V(8); PG8_WAIT_L(0); PG8_BAR; PG8_MMA(0, 0, At, B0); PG8_MMA(0, 1, At, B1); PG8_BAR; PG8_SCHED;
            PG8_LDA(At, 1, 1); PG8_STAGE(PG8_SB(1, 0), b3, voffB); PG8_STAGE(PG8_SB(1, 1), b3 + hstep, voffB); PG8_STAGE(PG8_SA(1, 0), a3, voffA);
            PG8_WAIT_V(8); PG8_WAIT_L(0); PG8_BAR; PG8_MMA(1, 0, At, B0); PG8_MMA(1, 1, At, B1); PG8_BAR; PG8_SCHED;
            } else {
            PG8_LDB(B0, 0, 0); PG8_SCHED; PG8_LDA(At, 0, 0); PG8_STAGE(PG8_SA(1, 1), a1 + hstep, voffA);
            PG8_WAIT_L(8); PG8_BAR; PG8_WAIT_L(0); PG8_MMA(0, 0, At, B0); PG8_BAR; PG8_SCHED;
            PG8_LDB(B1, 0, 1); PG8_STAGE(PG8_SB(0, 0), b2, voffB);
            PG8_BAR; PG8_WAIT_L(0); PG8_MMA(0, 1, At, B1); PG8_BAR;
            PG8_LDA(At, 0, 1); PG8_STAGE(PG8_SA(0, 0), a2, voffA);
            PG8_BAR; PG8_WAIT_L(0); PG8_MMA(1, 0, At, B0); PG8_BAR; PG8_SCHED;
            PG8_STAGE(PG8_SB(0, 1), b2 + hstep, voffB);
            PG8_WAIT_V(6); PG8_BAR; PG8_MMA(1, 1, At, B1); PG8_BAR;
            PG8_LDB(B0, 1, 0); PG8_SCHED; PG8_LDA(At, 1, 0); PG8_STAGE(PG8_SA(0, 1), a2 + hstep, voffA);
            PG8_WAIT_L(8); PG8_BAR; PG8_WAIT_L(0); PG8_MMA(0, 0, At, B0); PG8_BAR; PG8_SCHED;
            PG8_LDB(B1, 1, 1); PG8_STAGE(PG8_SB(1, 0), b3, voffB);
            PG8_BAR; PG8_WAIT_L(0); PG8_MMA(0, 1, At, B1); PG8_BAR;
            PG8_LDA(At, 1, 1); PG8_STAGE(PG8_SA(1, 0), a3, voffA);
            PG8_BAR; PG8_WAIT_L(0); PG8_MMA(1, 0, At, B0); PG8_BAR; PG8_SCHED;
            PG8_STAGE(PG8_SB(1, 1), b3 + hstep, voffB);
            PG8_WAIT_V(6); PG8_BAR; PG8_MMA(1, 1, At, B1); PG8_BAR;
            }
        }
        if constexpr (ALIGN_EPI) { if (wr == 0) PG8_BAR; }
        if constexpr (!Epi::AFTER_DRAIN) { E(acc, cur, wr, wc, fr, fq); S.done(cur); }
        if (!has_next) break;
#pragma unroll
        for (int a = 0; a < 2; ++a)
#pragma unroll
            for (int b = 0; b < 2; ++b)
#pragma unroll
                for (int m = 0; m < 4; ++m)
#pragma unroll
                    for (int n = 0; n < 2; ++n) acc[a][b][m][n] = (f32x4){0.f, 0.f, 0.f, 0.f};
        cur = nxt; cA = nA; cB = nB; ++ui;
        if constexpr (ALIGN_EPI) { if (wr == 1) PG8_BAR; }
    }
    PG8_WAIT_V(0);
    if constexpr (!ALIGN_EPI) { if (wr == 0) PG8_BAR; }
    PG8_BAR;
    if constexpr (Epi::AFTER_DRAIN) { E.fused(acc, cur, wr, wc, fr, fq, lds, wid, lane); S.done(cur); }
#undef PG8_SA
#undef PG8_SB
#undef PG8_STAGE
#undef PG8_LDA
#undef PG8_LDB
#undef PG8_MMA
#undef PG8_WAIT_V
#undef PG8_WAIT_L
#undef PG8_BAR
#undef PG8_SCHED
}
}
#define GAS __attribute__((address_space(1)))
#define LAS __attribute__((address_space(3)))
typedef unsigned short bf16;
typedef unsigned v4u __attribute__((ext_vector_type(4)));
typedef float f32x4 __attribute__((ext_vector_type(4)));
typedef short bf16x8 __attribute__((ext_vector_type(8)));
typedef GAS unsigned gu32;
typedef GAS unsigned long long gu64;
#define RLX_AGENT __ATOMIC_RELAXED, __HIP_MEMORY_SCOPE_AGENT
#define LDS_WAIT() asm volatile("s_waitcnt lgkmcnt(0)" ::: "memory")
#define VM_WAIT() asm volatile("s_waitcnt vmcnt(0)" ::: "memory")
__device__ __forceinline__ unsigned long long rt() { return __builtin_amdgcn_s_memrealtime(); }
__device__ __forceinline__ unsigned pk2(float lo, float hi) { return pg8::cvt_pk_bf16(lo, hi); }
__device__ __forceinline__ unsigned f2bf(float f) { return pg8::cvt_pk_bf16(f, 0.f) & 0xffffu; }

#define XB_TMO      128
#define XB_XCNT(j)  (256  + 64 * (j))
#define XB_XSUB(j)  (1280 + 64 * (j))
#define XB_XGEN(j)  (2304 + 64 * (j))
#define XB_TOP      3328
#define XB_TOPGEN   3392
#define XCD_BAR_WORDS 3456
#define XB_SPIN_CAP (1u << 18)

__device__ __forceinline__ unsigned xb_ld(unsigned* p)              { return __hip_atomic_load(p, __ATOMIC_RELAXED, __HIP_MEMORY_SCOPE_AGENT); }
__device__ __forceinline__ unsigned xb_add(unsigned* p, unsigned v) { return __hip_atomic_fetch_add(p, v, __ATOMIC_RELAXED, __HIP_MEMORY_SCOPE_AGENT); }
__device__ __forceinline__ unsigned xb_xcc_id() { return (unsigned)__builtin_amdgcn_s_getreg((3 << 11) | 20) & 0xFu; }
#define XB_SPIN(cond, bar) do { unsigned _sp = 0; while (cond) { __builtin_amdgcn_s_sleep(1); \
    if ((++_sp & 255u) == 0u) { if (xb_ld(&(bar)[XB_TMO])) break; if (_sp > XB_SPIN_CAP) { atomicAdd(&(bar)[XB_TMO], 1u); break; } } } } while (0)

struct XcdBarrier {
    unsigned* bar; unsigned x;
    volatile LAS unsigned* st;
};

__device__ __forceinline__ XcdBarrier xcd_barrier_post(unsigned* bar, volatile LAS unsigned* st) {
    XcdBarrier b; b.bar = bar; b.x = xb_xcc_id(); b.st = st;
    if (threadIdx.x == 0) (void)xb_add(&bar[XB_XCNT(b.x)], 1u);
    return b;
}
__device__ __forceinline__ void xcd_barrier_complete(unsigned* bar, unsigned x, unsigned& nloc, unsigned& nx) {
    const unsigned G = gridDim.x * gridDim.y * gridDim.z;
    unsigned sum, cnt, mine, sp = 0u;
    for (;;) {
        sum = 0u; cnt = 0u; mine = 0u;
#pragma unroll
        for (unsigned j = 0; j < 16; ++j) { const unsigned c = xb_ld(&bar[XB_XCNT(j)]); sum += c; cnt += (c > 0u) ? 1u : 0u; mine = (j == x) ? c : mine; }
        if (sum == G) break;
        __builtin_amdgcn_s_sleep(1);
        if ((++sp & 255u) == 0u) { if (xb_ld(&bar[XB_TMO])) break; if (sp > XB_SPIN_CAP) { atomicAdd(&bar[XB_TMO], 1u); break; } }
    }
    nloc = mine > 0u ? mine : 1u; nx = cnt > 0u ? cnt : 1u;
}

__device__ __forceinline__ void xcd_barrier(const XcdBarrier& b) {
    asm volatile("s_waitcnt vmcnt(0)" ::: "memory");
    __syncthreads();
    if (threadIdx.x == 0) {
        unsigned* bar = b.bar;
        __builtin_amdgcn_s_waitcnt(0);
        unsigned nloc = b.st[0], nx = b.st[1];
        if (nloc == 0u) { xcd_barrier_complete(bar, b.x, nloc, nx); b.st[0] = nloc; b.st[1] = nx; }
        const unsigned old = xb_add(&bar[XB_XSUB(b.x)], 1u);
        const unsigned gen = old / nloc;
        if (old + 1u == (gen + 1u) * nloc) {
            __builtin_amdgcn_fence(__ATOMIC_RELEASE, "agent");
            asm volatile("s_waitcnt vmcnt(0)" ::: "memory");
            const unsigned og = xb_add(&bar[XB_TOP], 1u);
            const unsigned tg = og / nx;
            if (og + 1u == (tg + 1u) * nx) xb_add(&bar[XB_TOPGEN], 1u);
            else XB_SPIN(xb_ld(&bar[XB_TOPGEN]) == tg, bar);
            __builtin_amdgcn_fence(__ATOMIC_ACQUIRE, "agent");
            xb_add(&bar[XB_XGEN(b.x)], 1u);
            asm volatile("s_waitcnt vmcnt(0)" ::: "memory");
        } else {
            XB_SPIN(xb_ld(&bar[XB_XGEN(b.x)]) == gen, bar);
            __builtin_amdgcn_fence(__ATOMIC_ACQUIRE, "agent");
            asm volatile("s_waitcnt vmcnt(0)" ::: "memory");
        }
    }
    __syncthreads();
}

#ifndef DUP_PHASE
#define DUP_PHASE -1
#endif
#ifndef MK_COOP_LAUNCH
#define MK_COOP_LAUNCH 1
#endif
#ifndef MK_PER_PHASE
#define MK_PER_PHASE 0
#endif
constexpr int NWAVES = 8, NTHR = NWAVES * 64;
constexpr int DM = 2048, MP = 8192, MS = 1024, MTOT = MP + MS, SEQ = 2048, NBAT = 4, DBAT = 128, DSEQ = 8, DEPTH = 2;
constexpr int PW = 512, CW = 768, SW = 768, INW = 4352, FF = 5632, FF2 = 2 * FF, PHIST = 15;
constexpr int O1 = 512, O2 = 1280, O3 = 2048, O4 = 2816, O5 = 3584;
constexpr float EPS = 1e-6f;
#ifndef MIX_DUP
#define MIX_DUP 0
#endif
#ifndef G3_LAST_CUS
#define G3_LAST_CUS 0
#endif
#ifndef WGM_G1
#define WGM_G1 4
#endif
#ifndef WGM_G2
#define WGM_G2 4
#endif
#ifndef WGM_G3
#define WGM_G3 4
#endif
#ifndef WGM_G4
#define WGM_G4 4
#endif
#ifndef NS2
#define NS2 4
#endif
constexpr int NPHASE = 1 + 8 * DEPTH, NSPLIT = 8;
constexpr size_t OUT_POOLP = (size_t)MTOT * DM, OUT_POOLS = OUT_POOLP + (size_t)DEPTH * NBAT * PHIST * PW, OUT_CONVP = OUT_POOLS + (size_t)DEPTH * DBAT * PHIST * PW,
                 OUT_CONVS = OUT_CONVP + (size_t)DEPTH * NBAT * 2 * CW, OUT_FFNP = OUT_CONVS + (size_t)DEPTH * DBAT * 2 * CW, OUT_FFNS = OUT_FFNP + (size_t)DEPTH * NBAT * 2 * FF,
                 OUT_VS = OUT_FFNS + (size_t)DEPTH * DBAT * 2 * FF, OUT_END = OUT_VS + (size_t)DEPTH * DBAT * DSEQ * SW;
static_assert(OUT_END == 25853952, "d_out map");
constexpr size_t MiB = 1u << 20;
constexpr size_t WS_CTL = 0, CTL_ZERO_BYTES = 64 * 1024;
constexpr size_t WS_WIN = 1 * MiB, WIN_L = 17 * MiB, WS_WOUT = 35 * MiB, WOUT_L = 8 * MiB, WS_WUP = 51 * MiB, WUP_L = 44 * MiB, WS_WDN = 139 * MiB, WDN_L = 22 * MiB;
constexpr size_t WS_SGUW = 183 * MiB, WS_RINV = 184 * MiB, WS_SSQP = 185 * MiB, WS_XB = 187 * MiB, WS_MIX = 223 * MiB, WS_R1 = 295 * MiB, WS_R2 = 493 * MiB, WS_HALO = 592 * MiB, WS_SHALO = 598 * MiB, WS_PART = 610 * MiB, WS_END = 674 * MiB;
constexpr size_t HALO_SZ = (size_t)32 * 2 * FF;
constexpr size_t SHALO_SZ = (size_t)DBAT * 2 * FF;
static_assert(3 * HALO_SZ * 4 <= 6 * MiB && 2 * SHALO_SZ * 4 <= 12 * MiB, "halo buffers");
static_assert((size_t)INW * DM * 2 == WIN_L && (size_t)DM * DM * 2 == WOUT_L && (size_t)FF2 * DM * 2 == WUP_L && (size_t)DM * FF * 2 == WDN_L, "weight copies");
static_assert((size_t)MTOT * DM * 2 == 36 * MiB && (size_t)MTOT * DM * 4 == 72 * MiB && (size_t)MTOT * FF2 * 2 == 198 * MiB && (size_t)MTOT * FF * 2 == 99 * MiB, "activation buffers");
constexpr size_t WS_VPART = WS_SSQP + 1536 * 1024;
static_assert((size_t)MTOT * 32 * 4 <= 1536 * 1024 && (size_t)MTOT * 12 * 4 <= 512 * 1024, "ssq partial buffers");
constexpr int CW_BAR = 4096, CW_CENS = 8192;
static_assert((CW_CENS + 16 * 64) * 4 <= (int)CTL_ZERO_BYTES && (CW_BAR + 3456) <= CW_CENS, "control words inside the zeroed region");
constexpr int RING_OFF = 0, RING_BYTES = 131072, LDSCTL_OFF = RING_BYTES, MISC_OFF = LDSCTL_OFF + 320, XCH_OFF = RING_BYTES + 1024  , LDS_BYTES = 147456;

struct Args {
    const float *x_prompt, *x_sample, *state_pool, *state_conv, *state_ffn, *g_mix_pre, *g_mix_post, *g_ffn_pre, *g_ffn_post, *w_in, *pool_w, *pool_scale, *conv_w, *sgu_norm, *sgu_w, *sgu_b, *w_out,
        *ffn_up, *ffn_conv_w, *ffn_conv_b, *ffn_down;
    float* out; unsigned char* ws; int ph_lo, ph_hi;
};

typedef const __attribute__((address_space(4))) Args* ArgsP;
__device__ __forceinline__ ArgsP launder(ArgsP p) { asm volatile("" : "+s"(p)); return p; }

__device__ __forceinline__ float wave_sum(float v) {
#pragma unroll
    for (int o = 1; o < 64; o <<= 1) v += __shfl_xor(v, o);
    return v;
}
__device__ __forceinline__ float bflo(unsigned w) { return __builtin_bit_cast(float, w << 16); }
__device__ __forceinline__ float bfhi(unsigned w) { return __builtin_bit_cast(float, w & 0xffff0000u); }
__device__ __forceinline__ float bf1(bf16 b) { return __builtin_bit_cast(float, ((unsigned)b) << 16); }
__device__ __forceinline__ void unpack8(const v4u r, float (&f)[8]) { f[0] = bflo(r.x); f[1] = bfhi(r.x); f[2] = bflo(r.y); f[3] = bfhi(r.y); f[4] = bflo(r.z); f[5] = bfhi(r.z); f[6] = bflo(r.w); f[7] = bfhi(r.w); }
__device__ __forceinline__ v4u pack8(const float (&f)[8]) { v4u o; o.x = pk2(f[0], f[1]); o.y = pk2(f[2], f[3]); o.z = pk2(f[4], f[5]); o.w = pk2(f[6], f[7]); return o; }
__device__ __forceinline__ void ld8f(const float* p, float (&f)[8]) { const f32x4 a = *(const f32x4*)p, b = *(const f32x4*)(p + 4); f[0] = a.x; f[1] = a.y; f[2] = a.z; f[3] = a.w; f[4] = b.x; f[5] = b.y; f[6] = b.z; f[7] = b.w; }
__device__ __forceinline__ void st8f(float* p, const float (&f)[8]) { *(f32x4*)p = (f32x4){f[0], f[1], f[2], f[3]}; *(f32x4*)(p + 4) = (f32x4){f[4], f[5], f[6], f[7]}; }

__device__ __forceinline__ void tr_load(const float* W, int ldw, int k0, int n0, int lane, float (&v)[64]) {
    const float* src = W + (size_t)k0 * ldw + n0 + lane;
#pragma unroll
    for (int i = 0; i < 64; ++i) v[i] = src[(size_t)i * ldw];
}
__device__ __forceinline__ void tr_finish(float (&v)[64], bool has_gain, float gl  , bf16* WT, int ldk, LAS unsigned char* scr, int k0, int n0, int lane) {
    if (has_gain) {
#pragma unroll
        for (int i = 0; i < 64; ++i) v[i] *= __builtin_bit_cast(float, __builtin_amdgcn_readlane(__builtin_bit_cast(int, gl), i)); }
#pragma unroll
    for (int c = 0; c < 8; ++c) { v4u o; o.x = pk2(v[8 * c], v[8 * c + 1]); o.y = pk2(v[8 * c + 2], v[8 * c + 3]); o.z = pk2(v[8 * c + 4], v[8 * c + 5]); o.w = pk2(v[8 * c + 6], v[8 * c + 7]);
        *(LAS v4u*)(scr + lane * 144 + c * 16) = o; }
    LDS_WAIT(); asm volatile("" ::: "memory");
#pragma unroll
    for (int p = 0; p < 8; ++p) { const int n = p * 8 + (lane >> 3), c = lane & 7; const v4u o = *(const LAS v4u*)(scr + n * 144 + c * 16);
        *(GAS v4u*)(WT + (size_t)(n0 + n) * ldk + k0 + 8 * c) = o; }
    LDS_WAIT(); asm volatile("" ::: "memory");
}
template <class DstRow> __device__ __forceinline__ void tr_range(const float* W, int ldw, const float* gain, bf16* WT, int ldk, LAS unsigned char* scr, int nb, int kofs, int lo, int hi, int widx, int nw, int lane, DstRow drow) {
    for (int r = lo + widx; r < hi; r += 2 * nw) { const int r2 = r + nw; const bool two = r2 < hi;
        float va[64], vb[64]; const int ka = kofs + 64 * (r / nb), na = 64 * (r % nb), kb = kofs + 64 * ((two ? r2 : r) / nb), nbk = 64 * ((two ? r2 : r) % nb);
        const float gla = gain ? gain[ka + lane] : 1.f, glb = gain ? gain[kb + lane] : 1.f;
        tr_load(W, ldw, ka, na, lane, va); if (two) tr_load(W, ldw, kb, nbk, lane, vb);
        tr_finish(va, gain != nullptr, gla, WT, ldk, scr, ka, drow(na), lane);
        if (two) tr_finish(vb, gain != nullptr, glb, WT, ldk, scr, kb, drow(nbk), lane); }
}
__device__ __forceinline__ void x_row_to_bf16(const float* xrow, bf16* orow, float* rinv, int lane) {
    const f32x4* xr = (const f32x4*)xrow + lane; f32x4 v[8]; float s = 0.f;
#pragma unroll
    for (int j = 0; j < 8; ++j) { v[j] = xr[64 * j]; s += (v[j].x * v[j].x + v[j].y * v[j].y) + (v[j].z * v[j].z + v[j].w * v[j].w); }
    s = wave_sum(s);
    unsigned long long* o8 = (unsigned long long*)orow + lane;
#pragma unroll
    for (int j = 0; j < 8; ++j) o8[64 * j] = (unsigned long long)pk2(v[j].x, v[j].y) | ((unsigned long long)pk2(v[j].z, v[j].w) << 32);
    if (lane == 0) *rinv = rsqrtf(s * (1.f / DM) + EPS);
}
enum ConvJob { J_IN = 0, J_OUT = 1, J_FOLD = 2, J_UP = 3, J_DN = 4 };
typedef float f32x16 __attribute__((ext_vector_type(16)));
__device__ __forceinline__ void conv_job(ArgsP AP, unsigned char* ws, LAS unsigned char* lds, int job, int l, int part, int nparts, int widx, int nw, int lane, int wave) {
    LAS unsigned char* scr = lds + RING_OFF + wave * 16384;
    auto same = [](int n) { return n; };
    if (job == J_IN) { constexpr int nb = INW / 64, n = (DM / 64) * nb;
        tr_range(AP->w_in + (size_t)l * DM * INW, INW, AP->g_mix_pre + l * DM, (bf16*)(ws + WS_WIN + l * WIN_L), DM, scr, nb, 0, (int)((long)n * part / nparts), (int)((long)n * (part + 1) / nparts), widx, nw, lane, same); }
    else if (job == J_OUT) { constexpr int nb = DM / 64, n = ((DM - PW) / 64) * nb;
        tr_range(AP->w_out + (size_t)l * DM * DM, DM, nullptr, (bf16*)(ws + WS_WOUT + l * WOUT_L), DM, scr, nb, PW, (int)((long)n * part / nparts), (int)((long)n * (part + 1) / nparts), widx, nw, lane, same); }
    else if (job == J_UP) { constexpr int nb = FF2 / 64, n = (DM / 64) * nb;
        auto inter = [](int n0) { const int n2 = n0 < FF ? n0 : n0 - FF; return 256 * (n2 / 128) + (n2 % 128) + (n0 < FF ? 0 : 128); };
        tr_range(AP->ffn_up + (size_t)l * DM * FF2, FF2, AP->g_ffn_pre + l * DM, (bf16*)(ws + WS_WUP + l * WUP_L), DM, scr, nb, 0, (int)((long)n * part / nparts), (int)((long)n * (part + 1) / nparts), widx, nw, lane, inter); }
    else if (job == J_DN) { constexpr int nb = DM / 64, n = (FF / 64) * nb;
        tr_range(AP->ffn_down + (size_t)l * FF * DM, DM, nullptr, (bf16*)(ws + WS_WDN + l * WDN_L), FF, scr, nb, 0, (int)((long)n * part / nparts), (int)((long)n * (part + 1) / nparts), widx, nw, lane, same); }
    else {
        const int ntile = 4 * 64 * 4, lo = (int)((long)ntile * part / nparts), hi = (int)((long)ntile * (part + 1) / nparts);
        for (int t = lo + widx; t < hi; t += nw) { const int g = t >> 8, nblk = (t >> 2) & 63, cblk = t & 3, n0 = nblk * 32, c0 = cblk * 32, li = lane & 31, lk = lane >> 5;
            const float* wo = AP->w_out + (size_t)l * DM * DM + (size_t)(g * 128 + lk) * DM + n0 + li; const float* pw = AP->pool_w + ((size_t)(l * 4 + g) * 128 + c0 + li) * 128 + lk; const float* sc = AP->pool_scale + l * PW + g * 128 + lk;
            float a[64], b[64];
#pragma unroll
            for (int s = 0; s < 64; ++s) { a[s] = wo[(size_t)(2 * s) * DM] * sc[2 * s]; b[s] = pw[2 * s]; }
            f32x16 acc;
#pragma unroll
            for (int r = 0; r < 16; ++r) acc[r] = 0.f;
#pragma unroll
            for (int s = 0; s < 64; ++s) acc = __builtin_amdgcn_mfma_f32_32x32x2f32(a[s], b[s], acc, 0, 0, 0);
            bf16* dst = (bf16*)(ws + WS_WOUT + l * WOUT_L) + (size_t)n0 * DM + g * 128 + c0 + li;
#pragma unroll
            for (int r = 0; r < 16; ++r) dst[(size_t)((r & 3) + 8 * (r >> 2) + 4 * lk) * DM] = (bf16)f2bf(acc[r]);
        }
    }
}
__device__ __forceinline__ int gemm_cus(int nwg, int G) { const int R = (nwg + G - 1) / G; int g = ((nwg + R - 1) / R + 7) & ~7; return g < G ? g : G; }
__device__ __forceinline__ void conv_helper(ArgsP AP, unsigned char* ws, LAS unsigned char* lds, int slot, int l, int hidx, int nh, int lane, int wave) {
    const int widx = hidx * NWAVES + wave, nw = nh * NWAVES;
    if (slot == 0) conv_job(AP, ws, lds, J_UP, l, 0, 1, widx, nw, lane, wave);
    else if (slot == 1) conv_job(AP, ws, lds, J_DN, l, 0, 1, widx, nw, lane, wave);
    else if (l + 1 < DEPTH) {
        conv_job(AP, ws, lds, J_IN, l + 1, 0, 1, widx, nw, lane, wave); conv_job(AP, ws, lds, J_OUT, l + 1, 0, 1, widx, nw, lane, wave); conv_job(AP, ws, lds, J_FOLD, l + 1, 0, 1, widx, nw, lane, wave); }
}
__device__ __forceinline__ void x_row_finish(const f32x4 (&v)[8], bf16* orow, float* rinv, int lane) {
    float s = 0.f;
#pragma unroll
    for (int j = 0; j < 8; ++j) s += (v[j].x * v[j].x + v[j].y * v[j].y) + (v[j].z * v[j].z + v[j].w * v[j].w);
    s = wave_sum(s);
    unsigned long long* o8 = (unsigned long long*)orow + lane;
#pragma unroll
    for (int j = 0; j < 8; ++j) o8[64 * j] = (unsigned long long)pk2(v[j].x, v[j].y) | ((unsigned long long)pk2(v[j].z, v[j].w) << 32);
    if (lane == 0) *rinv = rsqrtf(s * (1.f / DM) + EPS);
}
__device__ __forceinline__ void p0_prologue(ArgsP AP, LAS unsigned char* lds, int tid, int lane, int wave, int vb, int G) {
    unsigned char* ws = AP->ws;
    const int gw = vb * NWAVES + wave, NGW = G * NWAVES;
    conv_job(AP, ws, lds, J_FOLD, 0, 0, 1, gw, NGW, lane, wave);
    conv_job(AP, ws, lds, J_IN, 0, 0, 1, gw, NGW, lane, wave);
    conv_job(AP, ws, lds, J_OUT, 0, 0, 1, gw, NGW, lane, wave);
    { bf16* sw = (bf16*)(ws + WS_SGUW);
      for (int i = vb * NTHR + tid; i < DEPTH * 6 * 128 * 128; i += G * NTHR) { const int q = (i >> 7) & 127, s = i & 127; sw[i] = (bf16)(s <= q ? f2bf(AP->sgu_w[i]) : 0u); } }
    for (int m = gw; m < MTOT; m += NGW) { const float* src = m < MP ? AP->x_prompt + (size_t)m * DM : AP->x_sample + (size_t)(m - MP) * DM;
        x_row_to_bf16(src, (bf16*)(ws + WS_XB) + (size_t)m * DM, (float*)(ws + WS_RINV) + m, lane); }
}

__device__ __forceinline__ float v_row_rinv(const bf16* Pb, int row, int lane) {
    const uint2* src = (const uint2*)(Pb + (size_t)row * INW + O5 + lane * 12); float q = 0.f;
#pragma unroll
    for (int i = 0; i < 3; ++i) { const uint2 a = src[i]; const float f0 = bflo(a.x), f1 = bfhi(a.x), f2 = bflo(a.y), f3 = bfhi(a.y); q += (f0 * f0 + f1 * f1) + (f2 * f2 + f3 * f3); }
    q = wave_sum(q);
    return rsqrtf(q * (1.f / SW) + EPS);
}
template <int WIN> __device__ __forceinline__ void pool_ld_p(const bf16* Pb, int m, int t, int c0, v4u (&raw)[WIN]) {
#pragma unroll
    for (int j = 0; j < WIN; ++j) raw[j] = *(const v4u*)(Pb + (size_t)(t - j >= 0 ? m - j : m) * INW + c0);
}
template <int WIN> __device__ __forceinline__ void pool_red_p(const v4u (&raw)[WIN], int t, float (&o)[8]) {
    float s[8], cur[8]; unpack8(raw[0], cur);
#pragma unroll
    for (int e = 0; e < 8; ++e) s[e] = cur[e];
#pragma unroll
    for (int j = 1; j < WIN; ++j) { float fv[8]; unpack8(raw[j], fv); const float k = t - j >= 0 ? 1.f : 0.f;
#pragma unroll
        for (int e = 0; e < 8; ++e) s[e] += k * fv[e]; }
    const float ic = 1.f / (float)(t + 1 < WIN ? t + 1 : WIN);
#pragma unroll
    for (int e = 0; e < 8; ++e) o[e] = s[e] * ic - cur[e];
}
template <int WIN> __device__ __forceinline__ void pool_samp(ArgsP AP, const bf16* Pb, bf16* MC, int l, int m, int c0) {
    constexpr int NP = WIN < 8 ? WIN : 8, NS = WIN - 1;
    const int si = (m - MP) >> 3, t = (m - MP) & 7; const float* prev = AP->state_pool + ((size_t)(l * DBAT + si) * PHIST) * PW + c0;
    v4u raw[NP]; f32x4 sa[NS], sb[NS];
#pragma unroll
    for (int j = 0; j < NP; ++j) raw[j] = *(const v4u*)(Pb + (size_t)(j <= t ? m - j : m) * INW + c0);
#pragma unroll
    for (int i = 0; i < NS; ++i) { int pr = PHIST + t - (i + 1); pr = pr < 0 ? 0 : (pr > PHIST - 1 ? PHIST - 1 : pr); sa[i] = *(const f32x4*)(prev + (size_t)pr * PW); sb[i] = *(const f32x4*)(prev + (size_t)pr * PW + 4); }
    float s[8], cur[8]; unpack8(raw[0], cur);
#pragma unroll
    for (int e = 0; e < 8; ++e) s[e] = cur[e];
#pragma unroll
    for (int j = 1; j < NP; ++j) { float fv[8]; unpack8(raw[j], fv); const float k = j <= t ? 1.f : 0.f;
#pragma unroll
        for (int e = 0; e < 8; ++e) s[e] += k * fv[e]; }
#pragma unroll
    for (int i = 0; i < NS; ++i) { const float k = (i + 1) > t ? 1.f : 0.f; s[0] += k * sa[i].x; s[1] += k * sa[i].y; s[2] += k * sa[i].z; s[3] += k * sa[i].w; s[4] += k * sb[i].x; s[5] += k * sb[i].y; s[6] += k * sb[i].z; s[7] += k * sb[i].w; }
    float o[8];
#pragma unroll
    for (int e = 0; e < 8; ++e) o[e] = s[e] * (1.f / (float)WIN) - cur[e];
    *(v4u*)(MC + (size_t)m * DM + c0) = pack8(o);
}
__device__ __forceinline__ void phase_mixers(ArgsP AP, int l, LAS unsigned char* lds, int tid, int lane, int wave, int vb, int G) {
    unsigned char* ws = AP->ws; const bf16* Pb = (const bf16*)(ws + WS_R1); bf16* MC = (bf16*)(ws + WS_R2); const bf16* SGW = (const bf16*)(ws + WS_SGUW); const float* VP = (const float*)(ws + WS_VPART);
    LAS float* rv = (LAS float*)lds; LAS bf16* vnT = (LAS bf16*)(lds + 512); constexpr int LDV = 136, LDG = 132; LAS float* GT = (LAS float*)(lds + 36864);
    constexpr int U_SP = (MP / 128) * 6, U_SS = DBAT, NU = U_SP + U_SS;
    for (int rp = 0; rp < (MIX_DUP == 1 ? 2 : 1); ++rp)
    for (int u = vb; u < NU; u += G) {
        if (u < U_SP) {
            const int cidx = u / 6, h = u % 6, r0 = cidx * 128;
            const int wq = wave >> 1, wd = wave & 1, fr = lane & 15, fq = lane >> 4;
            const bf16* Wg = SGW + (size_t)(l * 6 + h) * 128 * 128;
            v4u vraw[4], uraw[4]; bf16x8 af[4][2]; f32x4 vpa, vpb, vpc;
#pragma unroll
            for (int i = 0; i < 4; ++i) { const int vec = tid + NTHR * i; vraw[i] = *(const v4u*)(Pb + (size_t)(r0 + (vec & 127)) * INW + O5 + h * 128 + (vec >> 7) * 8);
                uraw[i] = *(const v4u*)(Pb + (size_t)(r0 + (vec >> 4)) * INW + O4 + h * 128 + (vec & 15) * 8); }
#pragma unroll
            for (int ks = 0; ks < 4; ++ks)
#pragma unroll
                for (int mi = 0; mi < 2; ++mi) af[ks][mi] = *(const bf16x8*)(Wg + (size_t)(32 * wq + 16 * mi + fr) * 128 + 32 * (ks <= wq ? ks : 0) + 8 * fq);
            { const f32x4* vp = (const f32x4*)(VP + (size_t)(r0 + (tid & 127)) * 12); vpa = vp[0]; vpb = vp[1]; vpc = vp[2]; }
            f32x4 nra[4], nrb[4]; float bqv[4];
#pragma unroll
            for (int i = 0; i < 4; ++i) { const int vec = tid + NTHR * i; const float* np = AP->sgu_norm + l * SW + h * 128 + (vec >> 7) * 8; nra[i] = *(const f32x4*)np; nrb[i] = *(const f32x4*)(np + 4); bqv[i] = AP->sgu_b[(l * 6 + h) * 128 + (vec >> 4)]; }
            if (tid < 128) rv[tid] = rsqrtf((((vpa.x + vpa.y) + (vpa.z + vpa.w)) + ((vpb.x + vpb.y) + (vpb.z + vpb.w)) + ((vpc.x + vpc.y) + (vpc.z + vpc.w))) * (1.f / SW) + EPS);
            __syncthreads();
#pragma unroll
            for (int i = 0; i < 4; ++i) { const int vec = tid + NTHR * i, s = vec & 127, d0 = (vec >> 7) * 8; float fv[8], nr[8];
                unpack8(vraw[i], fv); nr[0] = nra[i].x; nr[1] = nra[i].y; nr[2] = nra[i].z; nr[3] = nra[i].w; nr[4] = nrb[i].x; nr[5] = nrb[i].y; nr[6] = nrb[i].z; nr[7] = nrb[i].w; const float rs = rv[s];
#pragma unroll
                for (int e = 0; e < 8; ++e) vnT[(d0 + e) * LDV + s] = (bf16)f2bf(fv[e] * rs * nr[e]); }
            __syncthreads();
            f32x4 acc[2][4];
#pragma unroll
            for (int mi = 0; mi < 2; ++mi)
#pragma unroll
                for (int ni = 0; ni < 4; ++ni) acc[mi][ni] = (f32x4){0.f, 0.f, 0.f, 0.f};
#pragma unroll
            for (int ks = 0; ks < 4; ++ks) if (ks <= wq) {
                bf16x8 b[4];
#pragma unroll
                for (int ni = 0; ni < 4; ++ni) b[ni] = *(const LAS bf16x8*)(vnT + (64 * wd + 16 * ni + fr) * LDV + 32 * ks + 8 * fq);
#pragma unroll
                for (int mi = 0; mi < 2; ++mi)
#pragma unroll
                    for (int ni = 0; ni < 4; ++ni) acc[mi][ni] = __builtin_amdgcn_mfma_f32_16x16x32_bf16(af[ks][mi], b[ni], acc[mi][ni], 0, 0, 0);
            }
#pragma unroll
            for (int mi = 0; mi < 2; ++mi)
#pragma unroll
                for (int j = 0; j < 4; ++j)
#pragma unroll
                    for (int ni = 0; ni < 4; ++ni) GT[(32 * wq + 16 * mi + 4 * fq + j) * LDG + 64 * wd + 16 * ni + fr] = acc[mi][ni][j];
            __syncthreads();
#pragma unroll
            for (int i = 0; i < 4; ++i) { const int vec = tid + NTHR * i, q = vec >> 4, d0 = (vec & 15) * 8; float uu[8], o[8]; unpack8(uraw[i], uu);
                const f32x4 ga = *(const LAS f32x4*)(GT + q * LDG + d0), gb = *(const LAS f32x4*)(GT + q * LDG + d0 + 4); const float bq = bqv[i];
                o[0] = uu[0] * (ga.x + bq); o[1] = uu[1] * (ga.y + bq); o[2] = uu[2] * (ga.z + bq); o[3] = uu[3] * (ga.w + bq); o[4] = uu[4] * (gb.x + bq); o[5] = uu[5] * (gb.y + bq); o[6] = uu[6] * (gb.z + bq); o[7] = uu[7] * (gb.w + bq);
                *(v4u*)(MC + (size_t)(r0 + q) * DM + O2 + h * 128 + d0) = pack8(o); }
            __syncthreads();
        } else {
            const int si = u - U_SP, r0 = MP + 8 * si;
            if (tid < SW / 8) { const int c0 = tid * 8, h = c0 >> 7;
                v4u rvv[8], ruu[8]; f32x4 wq[8][2], na, nb, ba, bb; float rs8[8];
                { f32x4 vp[8][3];
#pragma unroll
                  for (int t = 0; t < 8; ++t) { const f32x4* p = (const f32x4*)(VP + (size_t)(r0 + t) * 12); vp[t][0] = p[0]; vp[t][1] = p[1]; vp[t][2] = p[2]; }
#pragma unroll
                  for (int t = 0; t < 8; ++t) { const f32x4 a = vp[t][0], b = vp[t][1], c = vp[t][2]; rs8[t] = rsqrtf((((a.x + a.y) + (a.z + a.w)) + ((b.x + b.y) + (b.z + b.w)) + ((c.x + c.y) + (c.z + c.w))) * (1.f / SW) + EPS); }
                  asm volatile("" : "+v"(rs8[0]), "+v"(rs8[1]), "+v"(rs8[2]), "+v"(rs8[3]), "+v"(rs8[4]), "+v"(rs8[5]), "+v"(rs8[6]), "+v"(rs8[7])); }
#pragma unroll
                for (int t = 0; t < 8; ++t) { rvv[t] = *(const v4u*)(Pb + (size_t)(r0 + t) * INW + O5 + c0); ruu[t] = *(const v4u*)(Pb + (size_t)(r0 + t) * INW + O4 + c0);
                    const float* wr = AP->sgu_w + ((size_t)(l * 6 + h) * 128 + t) * 128; wq[t][0] = *(const f32x4*)wr; wq[t][1] = *(const f32x4*)(wr + 4); }
                { const float* np = AP->sgu_norm + l * SW + c0; na = *(const f32x4*)np; nb = *(const f32x4*)(np + 4); const float* bp = AP->sgu_b + (l * 6 + h) * 128; ba = *(const f32x4*)bp; bb = *(const f32x4*)(bp + 4); }
                const float nr[8] = {na.x, na.y, na.z, na.w, nb.x, nb.y, nb.z, nb.w}, bq[8] = {ba.x, ba.y, ba.z, ba.w, bb.x, bb.y, bb.z, bb.w};
                float vn[8][8];
#pragma unroll
                for (int t = 0; t < 8; ++t) { const float rs = rs8[t]; float fv[8]; unpack8(rvv[t], fv);
#pragma unroll
                    for (int e = 0; e < 8; ++e) vn[t][e] = fv[e] * rs * nr[e];
                    st8f(AP->out + OUT_VS + ((size_t)(l * DBAT + si) * DSEQ + t) * SW + c0, vn[t]); }
#pragma unroll
                for (int q = 0; q < 8; ++q) { const float wv[8] = {wq[q][0].x, wq[q][0].y, wq[q][0].z, wq[q][0].w, wq[q][1].x, wq[q][1].y, wq[q][1].z, wq[q][1].w}; float uu[8], o[8]; unpack8(ruu[q], uu);
#pragma unroll
                    for (int e = 0; e < 8; ++e) { float gq = bq[q];
#pragma unroll
                        for (int t = 0; t < 8; ++t) if (t <= q) gq += wv[t] * vn[t][e];
                        o[e] = uu[e] * gq; }
                    *(v4u*)(MC + (size_t)(r0 + q) * DM + O2 + c0) = pack8(o); }
            }
        }
    }
    for (int rp = 0; rp < (MIX_DUP == 2 ? 2 : 1); ++rp)
    for (int it = vb * NTHR + tid; it < MP * 16; it += G * NTHR) { const int m = it >> 4, cg = it & 15, t = m & (SEQ - 1);
        v4u r0[2], r1[4], r2[8], r3[16]; float o0[8], o1[8], o2[8], o3[8];
        pool_ld_p<2>(Pb, m, t, cg * 8, r0); pool_ld_p<4>(Pb, m, t, (16 + cg) * 8, r1); pool_ld_p<8>(Pb, m, t, (32 + cg) * 8, r2); pool_ld_p<16>(Pb, m, t, (48 + cg) * 8, r3);
        pool_red_p<2>(r0, t, o0); pool_red_p<4>(r1, t, o1); pool_red_p<8>(r2, t, o2); pool_red_p<16>(r3, t, o3);
        bf16* dst = MC + (size_t)m * DM + cg * 8; *(v4u*)dst = pack8(o0); *(v4u*)(dst + 128) = pack8(o1); *(v4u*)(dst + 256) = pack8(o2); *(v4u*)(dst + 384) = pack8(o3); }
    for (int it = vb * NTHR + tid; it < 4 * MS * 16; it += G * NTHR) { const int g = it / (MS * 16), r = it % (MS * 16), m = MP + (r >> 4), c0 = (g * 16 + (r & 15)) * 8;
        if (g == 0) pool_samp<2>(AP, Pb, MC, l, m, c0); else if (g == 1) pool_samp<4>(AP, Pb, MC, l, m, c0); else if (g == 2) pool_samp<8>(AP, Pb, MC, l, m, c0); else pool_samp<16>(AP, Pb, MC, l, m, c0); }
    for (int rp = 0; rp < (MIX_DUP == 3 ? 2 : 1); ++rp)
    for (int it0 = vb * NTHR + tid; it0 < MP * 96; it0 += 2 * G * NTHR) {
        v4u rc[2][3], rh[2][3], rb[2]; f32x4 wa[2][3], wb[2][3]; int mm[2], cc[2], tt[2]; const bool two = it0 + G * NTHR < MP * 96;
#pragma unroll
        for (int h = 0; h < 2; ++h) { const int it = (h && two) ? it0 + G * NTHR : it0; mm[h] = it / 96; cc[h] = (it % 96) * 8; tt[h] = mm[h] & (SEQ - 1);
#pragma unroll
            for (int j = 0; j < 3; ++j) { const int row = tt[h] - 2 + j >= 0 ? mm[h] - 2 + j : mm[h]; rc[h][j] = *(const v4u*)(Pb + (size_t)row * INW + O3 + cc[h]); rh[h][j] = *(const v4u*)(Pb + (size_t)row * INW + O1 + cc[h]);
                wa[h][j] = *(const f32x4*)(AP->conv_w + (size_t)(l * 3 + j) * CW + cc[h]); wb[h][j] = *(const f32x4*)(AP->conv_w + (size_t)(l * 3 + j) * CW + cc[h] + 4); }
            rb[h] = *(const v4u*)(Pb + (size_t)mm[h] * INW + O2 + cc[h]); }
#pragma unroll
        for (int h = 0; h < 2; ++h) if (h == 0 || two) { float acc8[8], bg[8];
#pragma unroll
            for (int e = 0; e < 8; ++e) acc8[e] = 0.f;
#pragma unroll
            for (int j = 0; j < 3; ++j) { float a[8], b[8]; unpack8(rc[h][j], a); unpack8(rh[h][j], b); const float k = tt[h] - 2 + j >= 0 ? 1.f : 0.f; const float w[8] = {wa[h][j].x, wa[h][j].y, wa[h][j].z, wa[h][j].w, wb[h][j].x, wb[h][j].y, wb[h][j].z, wb[h][j].w};
#pragma unroll
                for (int e = 0; e < 8; ++e) acc8[e] += k * w[e] * (a[e] * b[e]); }
            unpack8(rb[h], bg); float o[8];
#pragma unroll
            for (int e = 0; e < 8; ++e) o[e] = bg[e] * acc8[e];
            *(v4u*)(MC + (size_t)mm[h] * DM + O1 + cc[h]) = pack8(o); }
    }
    for (int it = vb * NTHR + tid; it < MS * 96; it += G * NTHR) { const int m = MP + it / 96, c0 = (it % 96) * 8, si = (m - MP) >> 3, t = (m - MP) & 7;
        v4u rc[3], rh[3], rb; f32x4 wa[3], wb[3], sa[3], sb[3];
#pragma unroll
        for (int j = 0; j < 3; ++j) { const int tj = t - 2 + j, row = tj >= 0 ? m - 2 + j : m; int pr = 2 + tj; pr = pr < 0 ? 0 : (pr > 1 ? 1 : pr);
            rc[j] = *(const v4u*)(Pb + (size_t)row * INW + O3 + c0); rh[j] = *(const v4u*)(Pb + (size_t)row * INW + O1 + c0);
            const float* sp = AP->state_conv + ((size_t)(l * DBAT + si) * 2 + pr) * CW + c0; sa[j] = *(const f32x4*)sp; sb[j] = *(const f32x4*)(sp + 4);
            wa[j] = *(const f32x4*)(AP->conv_w + (size_t)(l * 3 + j) * CW + c0); wb[j] = *(const f32x4*)(AP->conv_w + (size_t)(l * 3 + j) * CW + c0 + 4); }
        rb = *(const v4u*)(Pb + (size_t)m * INW + O2 + c0);
        float acc8[8], bg[8], o[8];
#pragma unroll
        for (int e = 0; e < 8; ++e) acc8[e] = 0.f;
#pragma unroll
        for (int j = 0; j < 3; ++j) { float a[8], b[8]; unpack8(rc[j], a); unpack8(rh[j], b); const bool ok = t - 2 + j >= 0; const float w[8] = {wa[j].x, wa[j].y, wa[j].z, wa[j].w, wb[j].x, wb[j].y, wb[j].z, wb[j].w}, sv8[8] = {sa[j].x, sa[j].y, sa[j].z, sa[j].w, sb[j].x, sb[j].y, sb[j].z, sb[j].w};
#pragma unroll
            for (int e = 0; e < 8; ++e) acc8[e] += w[e] * (ok ? a[e] * b[e] : sv8[e]); }
        unpack8(rb, bg);
#pragma unroll
        for (int e = 0; e < 8; ++e) o[e] = bg[e] * acc8[e];
        *(v4u*)(MC + (size_t)m * DM + O1 + c0) = pack8(o); }
    constexpr int S_PP = NBAT * PHIST * 64, S_PS = DBAT * PHIST * 64, S_CP = NBAT * 2 * 96, S_CS = DBAT * 2 * 96, S_ALL = S_PP + S_PS + S_CP + S_CS;
    for (int rp = 0; rp < (MIX_DUP == 4 ? 2 : 1); ++rp)
    for (int it = vb * NTHR + tid; it < S_ALL; it += G * NTHR) {
        int r = it; float f[8];
        if (r < S_PP) { const int cg = r % 64, i = (r / 64) % PHIST, b = r / (64 * PHIST); unpack8(*(const v4u*)(Pb + (size_t)(b * SEQ + SEQ - PHIST + i) * INW + cg * 8), f);
            st8f(AP->out + OUT_POOLP + ((size_t)(l * NBAT + b) * PHIST + i) * PW + cg * 8, f); continue; } r -= S_PP;
        if (r < S_PS) { const int cg = r % 64, i = (r / 64) % PHIST, si = r / (64 * PHIST);
            if (i < PHIST - DSEQ) ld8f(AP->state_pool + ((size_t)(l * DBAT + si) * PHIST + i + DSEQ) * PW + cg * 8, f); else unpack8(*(const v4u*)(Pb + (size_t)(MP + si * DSEQ + i - (PHIST - DSEQ)) * INW + cg * 8), f);
            st8f(AP->out + OUT_POOLS + ((size_t)(l * DBAT + si) * PHIST + i) * PW + cg * 8, f); continue; } r -= S_PS;
        if (r < S_CP) { const int cg = r % 96, i = (r / 96) % 2, b = r / 192; const int m = b * SEQ + SEQ - 2 + i; float a[8], c[8];
            unpack8(*(const v4u*)(Pb + (size_t)m * INW + O3 + cg * 8), a); unpack8(*(const v4u*)(Pb + (size_t)m * INW + O1 + cg * 8), c);
#pragma unroll
            for (int e = 0; e < 8; ++e) f[e] = a[e] * c[e];
            st8f(AP->out + OUT_CONVP + ((size_t)(l * NBAT + b) * 2 + i) * CW + cg * 8, f); continue; } r -= S_CP;
        { const int cg = r % 96, i = (r / 96) % 2, si = r / 192; const int m = MP + si * DSEQ + DSEQ - 2 + i; float a[8], c[8];
            unpack8(*(const v4u*)(Pb + (size_t)m * INW + O3 + cg * 8), a); unpack8(*(const v4u*)(Pb + (size_t)m * INW + O1 + cg * 8), c);
#pragma unroll
            for (int e = 0; e < 8; ++e) f[e] = a[e] * c[e];
            st8f(AP->out + OUT_CONVS + ((size_t)(l * DBAT + si) * 2 + i) * CW + cg * 8, f); }
    }
}

__device__ __forceinline__ void phase_postnorm(ArgsP AP, const float* gpost, bool first, bool last, int K, int nsplit, int wgm, int lane, int wave, int vb, int G) {
    unsigned char* ws = AP->ws; const bf16* MIXB = (const bf16*)(ws + WS_MIX); const float* PART = (const float*)(ws + WS_PART); bf16* XB = (bf16*)(ws + WS_XB);
    pg8::SplitTailOrder S; S.init(MTOT, DM, G, 0, K, nsplit, wgm);
    const int gw = vb * NWAVES + wave, NGW = G * NWAVES, hi = lane >> 5, cl = (lane & 31) * 8;
    for (int m = gw; m < MTOT; m += NGW) {
        const int pm = m >> 8, rl = m & 255; float y[4][8]; float q = 0.f;
        const float* xs = m < MP ? AP->x_prompt + (size_t)m * DM : AP->x_sample + (size_t)(m - MP) * DM;
        v4u ry[4], rx[4]; f32x4 xa[4], xb[4], ga[4], gb[4];
#pragma unroll
        for (int jj = 0; jj < 4; ++jj) { const int c = 512 * jj + 8 * lane; ry[jj] = *(const v4u*)(MIXB + (size_t)m * DM + c); ga[jj] = *(const f32x4*)(gpost + c); gb[jj] = *(const f32x4*)(gpost + c + 4);
            if (first) { xa[jj] = *(const f32x4*)(xs + c); xb[jj] = *(const f32x4*)(xs + c + 4); } else rx[jj] = *(const v4u*)(XB + (size_t)m * DM + c); }
#pragma unroll
        for (int jj = 0; jj < 4; ++jj) { const int s0 = S.tail_slot(pm, 2 * jj), s1 = S.tail_slot(pm, 2 * jj + 1), slot = hi ? s1 : s0;
            unpack8(ry[jj], y[jj]);
            if (s0 >= 0 || s1 >= 0) { if (slot >= 0) { const bf16* pp = (const bf16*)PART + (size_t)slot * 65536 + (size_t)rl * 256 + cl; unpack8(*(const v4u*)pp, y[jj]);
                    for (int s = 1; s < S.ns; ++s) { float t[8]; unpack8(*(const v4u*)(pp + (size_t)s * 65536), t);
#pragma unroll
                        for (int e = 0; e < 8; ++e) y[jj][e] += t[e]; } } }
#pragma unroll
            for (int e = 0; e < 8; ++e) q += y[jj][e] * y[jj][e]; }
        q = wave_sum(q); const float ri = rsqrtf(q * (1.f / DM) + EPS); float s = 0.f;
#pragma unroll
        for (int jj = 0; jj < 4; ++jj) { const int c = 512 * jj + 8 * lane; float x[8], v[8]; const float g[8] = {ga[jj].x, ga[jj].y, ga[jj].z, ga[jj].w, gb[jj].x, gb[jj].y, gb[jj].z, gb[jj].w};
            if (first) { x[0] = xa[jj].x; x[1] = xa[jj].y; x[2] = xa[jj].z; x[3] = xa[jj].w; x[4] = xb[jj].x; x[5] = xb[jj].y; x[6] = xb[jj].z; x[7] = xb[jj].w; } else unpack8(rx[jj], x);
#pragma unroll
            for (int e = 0; e < 8; ++e) { v[e] = x[e] + y[jj][e] * ri * g[e]; s += v[e] * v[e]; }
            if (last) st8f(AP->out + (size_t)m * DM + c, v); else *(v4u*)(XB + (size_t)m * DM + c) = pack8(v); }
        if (!last) { s = wave_sum(s); if (lane == 0) ((float*)(ws + WS_RINV))[m] = rsqrtf(s * (1.f / DM) + EPS); }
    }
}

template <int CTRL> __device__ __forceinline__ float dpp_mov(float x) { return __builtin_bit_cast(float, __builtin_amdgcn_mov_dpp(__builtin_bit_cast(int, x), CTRL, 0xf, 0xf, false)); }
template <int CTRL> __device__ __forceinline__ float dpp_upd(float old, float x) { return __builtin_bit_cast(float, __builtin_amdgcn_update_dpp(__builtin_bit_cast(int, old), __builtin_bit_cast(int, x), CTRL, 0xf, 0xf, false)); }
typedef float f32x2 __attribute__((ext_vector_type(2)));
__device__ __forceinline__ f32x2 gelu_mul2(f32x2 x, f32x2 v) {
    const f32x2 p = (x * x) * (-0.10294324f) + (-2.3022082f), y = p * x; f32x2 e; e.x = __builtin_amdgcn_exp2f(y.x); e.y = __builtin_amdgcn_exp2f(y.y);
    const f32x2 d = e + 1.0f; f32x2 r; r.x = __builtin_amdgcn_rcpf(d.x); r.y = __builtin_amdgcn_rcpf(d.y); return (x * v) * r;
}
__device__ __forceinline__ float gelu_tanh(float x) { const f32x2 r = gelu_mul2((f32x2){x, x}, (f32x2){1.f, 1.f}); return r.x; }
struct EpiGateConvGelu {
    static constexpr bool PERM = true, AFTER_DRAIN = false;
    ArgsP ap; unsigned char* ws; int l; LAS float* xch;
    template <bool SAMP> __device__ __forceinline__ void body(const pg8::f32x4 (&acc)[2][2][4][2], const pg8::Unit& u, int wr, int wc, int fr_in, int fq_in) const {
        using pg8::f32x4;
        int fr = fr_in, fq = fq_in; asm volatile("" : "+v"(fr), "+v"(fq));
        const int cfl = wc * 32 + 8 * fq, cf = u.pn * 128 + cfl, row0 = u.pm * 256 + wr * 64 + fr;
        const float* rs = (const float*)(ws + WS_RINV);
        bf16* H = (bf16*)(ws + WS_R2); float* halo = (float*)(ws + WS_HALO); float* shalo = (float*)(ws + WS_SHALO);
        float sv[2][4];
#pragma unroll
        for (int ai = 0; ai < 2; ++ai)
#pragma unroll
            for (int m = 0; m < 4; ++m) sv[ai][m] = rs[row0 + ai * 128 + m * 16];
        LAS float* wl = xch + 1024;
        { const int t = (wr * 4 + wc) * 64 + fq * 16 + fr; if (t < 128) { const float* cwt = ap->ffn_conv_w + (size_t)l * 3 * FF + u.pn * 128 + t;
              wl[t] = cwt[0]; wl[128 + t] = cwt[FF]; wl[256 + t] = cwt[2 * FF]; wl[384 + t] = ap->ffn_conv_b[(size_t)l * FF + u.pn * 128 + t]; } }
        if (fr >= 14) {
#pragma unroll
            for (int ai = 0; ai < 2; ++ai)
#pragma unroll
                for (int n = 0; n < 2; ++n) *(LAS f32x4*)(xch + (((ai * 2 + wr) * 2 + (fr - 14)) * 128 + cfl + 4 * n)) = acc[ai][0][3][n] * sv[ai][3]; }
        asm volatile("s_waitcnt lgkmcnt(0)" ::: "memory"); __builtin_amdgcn_s_barrier(); asm volatile("" ::: "memory");
#pragma unroll
        for (int ai = 0; ai < 2; ++ai) {
            const int s = ai * 2 + wr;
            f32x4 gm1[2];
#pragma unroll
            for (int n = 0; n < 2; ++n) { gm1[n] = (f32x4){0.f, 0.f, 0.f, 0.f}; if (s > 0) gm1[n] = *(const LAS f32x4*)(xch + (((s - 1) * 2 + (fr >= 14 ? fr - 14 : 0)) * 128 + cfl + 4 * n)); }
#pragma unroll
            for (int m = 0; m < 4; ++m) {
                const int grow = row0 + ai * 128 + m * 16; const float sc = sv[ai][m];
                unsigned hw[4]; int wo = cfl; asm volatile("" : "+v"(wo));
#pragma unroll
                for (int n = 0; n < 2; ++n) {
                    const f32x4 g0 = acc[ai][0][m][n] * sc, vv = acc[ai][1][m][n] * sc; f32x4 g1, g2;
#pragma unroll
                    for (int j = 0; j < 4; ++j) { const float pj = gm1[n][j], cj = g0[j]; const float t1 = dpp_mov<0x121>(pj), t2 = dpp_mov<0x122>(pj); g1[j] = dpp_upd<0x111>(t1, cj); g2[j] = dpp_upd<0x112>(t2, cj); }
                    if (SAMP) {
                        const int t = fr & 7, si = (grow - MP) >> 3;
                        if (t < 2) { float* o = shalo + ((size_t)si * 2 + t) * FF + cf + 4 * n; *(f32x4*)o = g0; *(f32x4*)(o + SHALO_SZ) = vv; }
                        if (t >= 6) *(f32x4*)(ap->out + OUT_FFNS + ((size_t)(l * DBAT + si) * 2 + (t - 6)) * FF + cf + 4 * n) = g0;
                    } else {
                        if (s == 0 && m == 0 && fr < 2) { float* o = halo + HALO_SZ + ((size_t)u.pm * 2 + fr) * FF + cf + 4 * n; *(f32x4*)o = g0; *(f32x4*)(o + HALO_SZ) = vv; }
                        if (s == 3 && m == 3 && fr >= 14) {
                            *(f32x4*)(halo + ((size_t)u.pm * 2 + (fr - 14)) * FF + cf + 4 * n) = g0;
                            if ((u.pm & 7) == 7) *(f32x4*)(ap->out + OUT_FFNP + ((size_t)(l * NBAT + (u.pm >> 3)) * 2 + (fr - 14)) * FF + cf + 4 * n) = g0; }
                    }
#pragma unroll
                    for (int jj = 0; jj < 2; ++jj) { const int j = 2 * jj;
                        const f32x2 a2 = {g2[j], g2[j + 1]}, a1 = {g1[j], g1[j + 1]}, a0 = {g0[j], g0[j + 1]}, av = {vv[j], vv[j + 1]};
                        const f32x2 k0 = *(const LAS f32x2*)(wl + wo + 4 * n + j), k1 = *(const LAS f32x2*)(wl + 128 + wo + 4 * n + j), k2 = *(const LAS f32x2*)(wl + 256 + wo + 4 * n + j), kb = *(const LAS f32x2*)(wl + 384 + wo + 4 * n + j);
                        const f32x2 x = k0 * a2 + (k1 * a1 + (k2 * a0 + kb)); const f32x2 hv = gelu_mul2(x, av); hw[2 * n + jj] = pg8::cvt_pk_bf16(hv.x, hv.y); }
                    gm1[n] = g0;
                }
                *(v4u*)(H + (size_t)grow * FF + cf) = (v4u){hw[0], hw[1], hw[2], hw[3]};
            }
        }
    }
    __device__ __forceinline__ void operator()(const pg8::f32x4 (&acc)[2][2][4][2], const pg8::Unit& u, int wr, int wc, int fr, int fq) const {
        if (u.pm >= MP / 256) body<true>(acc, u, wr, wc, fr, fq); else body<false>(acc, u, wr, wc, fr, fq);
    }
};
__device__ __forceinline__ void phase_halofix(ArgsP AP, int l, int tid, int vb, int G) {
    unsigned char* ws = AP->ws; bf16* H = (bf16*)(ws + WS_R2); const float* BOTG = (const float*)(ws + WS_HALO); const float* TOPG = BOTG + HALO_SZ; const float* TOPV = BOTG + 2 * HALO_SZ;
    const float* SG = (const float*)(ws + WS_SHALO); const float* SV = SG + SHALO_SZ;
    constexpr int CG = FF / 8, NP = 28 * 2 * CG, NS = DBAT * 2 * CG;
    for (int it = vb * NTHR + tid; it < NP + NS; it += G * NTHR) {
        float o[8]; int c0, grow; const float *p2, *p1, *p0, *pv;
        if (it < NP) {
            c0 = (it % CG) * 8; const int r = (it / CG) & 1, pi = it / (2 * CG), pm = (pi / 7) * 8 + (pi % 7) + 1;
            if (r == 0) { p2 = BOTG + ((size_t)(pm - 1) * 2 + 0) * FF; p1 = BOTG + ((size_t)(pm - 1) * 2 + 1) * FF; p0 = TOPG + ((size_t)pm * 2 + 0) * FF; }
            else { p2 = BOTG + ((size_t)(pm - 1) * 2 + 1) * FF; p1 = TOPG + ((size_t)pm * 2 + 0) * FF; p0 = TOPG + ((size_t)pm * 2 + 1) * FF; }
            pv = TOPV + ((size_t)pm * 2 + r) * FF; grow = pm * 256 + r;
        } else {
            const int i2 = it - NP; c0 = (i2 % CG) * 8; const int t = (i2 / CG) & 1, si = i2 / (2 * CG); const float* st = AP->state_ffn + ((size_t)(l * DBAT + si) * 2) * FF;
            if (t == 0) { p2 = st; p1 = st + FF; } else { p2 = st + FF; p1 = SG + ((size_t)si * 2) * FF; }
            p0 = SG + ((size_t)si * 2 + t) * FF; pv = SV + ((size_t)si * 2 + t) * FF; grow = MP + si * DSEQ + t;
        }
        const float* cw = AP->ffn_conv_w + (size_t)l * 3 * FF + c0; const float* cbp = AP->ffn_conv_b + (size_t)l * FF + c0;
        f32x4 L[8][2];
#pragma unroll
        for (int h = 0; h < 2; ++h) { L[0][h] = *(const f32x4*)(p2 + c0 + 4 * h); L[1][h] = *(const f32x4*)(p1 + c0 + 4 * h); L[2][h] = *(const f32x4*)(p0 + c0 + 4 * h); L[3][h] = *(const f32x4*)(pv + c0 + 4 * h);
            L[4][h] = *(const f32x4*)(cw + 4 * h); L[5][h] = *(const f32x4*)(cw + FF + 4 * h); L[6][h] = *(const f32x4*)(cw + 2 * FF + 4 * h); L[7][h] = *(const f32x4*)(cbp + 4 * h); }
#pragma unroll
        for (int h = 0; h < 2; ++h)
#pragma unroll
            for (int e = 0; e < 4; ++e) o[4 * h + e] = gelu_tanh(L[4][h][e] * L[0][h][e] + L[5][h][e] * L[1][h][e] + L[6][h][e] * L[2][h][e] + L[7][h][e]) * L[3][h][e];
        *(v4u*)(H + (size_t)grow * FF + c0) = pack8(o);
    }
}

struct EpiNull {
    static constexpr bool PERM = true, AFTER_DRAIN = false;
    __device__ __forceinline__ void operator()(const pg8::f32x4 (&acc)[2][2][4][2], const pg8::Unit&, int, int, int, int) const {
#pragma unroll
        for (int a = 0; a < 2; ++a)
#pragma unroll
            for (int b = 0; b < 2; ++b)
#pragma unroll
                for (int m = 0; m < 4; ++m)
#pragma unroll
                    for (int n = 0; n < 2; ++n) asm volatile("" :: "v"(acc[a][b][m][n]));
    }
};
struct SameUnitOrder { int n, nkt; __device__ bool next(int i, pg8::Unit& u) const { if (i >= n) return false; u.pm = 0; u.pn = 0; u.kt0 = 0; u.nkt = nkt; u.slab = -1; return true; }
    __device__ __forceinline__ void a_ready(const pg8::Unit&) const {} __device__ __forceinline__ void done(const pg8::Unit&) const {} };
#ifndef PROBE_LEAK
#define PROBE_LEAK 0
#endif
#ifndef PROBE_BASE
#define PROBE_BASE 0
#endif
#ifndef PROBE_NULL
#define PROBE_NULL 0
#endif
__global__ void __launch_bounds__(NTHR, 2) mk_fwd(Args kernarg_) {
    ArgsP AP = (ArgsP)__builtin_amdgcn_kernarg_segment_ptr();
    extern __shared__ __attribute__((aligned(16))) unsigned char lds_raw[];
    LAS unsigned char* lds0 = (LAS unsigned char*)lds_raw;
    volatile LAS unsigned* MISC = (volatile LAS unsigned*)(lds0 + MISC_OFF);
    const int tid0 = threadIdx.x, wave0 = __builtin_amdgcn_readfirstlane(tid0 >> 6);
    const int G0 = gridDim.x;
    unsigned char* ws0 = AP->ws;
    for (int u = tid0; u < (LDS_BYTES - LDSCTL_OFF) / 4; u += NTHR) ((LAS unsigned*)(lds0 + LDSCTL_OFF))[u] = 0u;
    __syncthreads();
    XcdBarrier bar; bar.bar = (unsigned*)(ws0 + WS_CTL) + CW_BAR; bar.x = 0; bar.st = nullptr;
    if (!MK_PER_PHASE) bar = xcd_barrier_post((unsigned*)(ws0 + WS_CTL) + CW_BAR, MISC + 8);
    if (tid0 == 0) { const unsigned x = xb_xcc_id(); MISC[10] = x; MISC[11] = MK_PER_PHASE ? 0u : xb_add((unsigned*)(ws0 + WS_CTL) + CW_CENS + 64 * x, 1u); MISC[12] = blockIdx.x; }
    __syncthreads();
    const int lo = AP->ph_lo, hi = AP->ph_hi;
#define IN(k) (lo <= (k) && (k) < hi)
#define NREP(k) (((k) == DUP_PHASE) ? 2 : 1)
#define OPAQUE_TID() int lane = (int)__builtin_amdgcn_mbcnt_hi(~0u, __builtin_amdgcn_mbcnt_lo(~0u, 0u)); asm volatile("" : "+v"(lane)); const int wave = wave0, tid = wave0 * 64 + lane; unsigned char* ws = launder(AP)->ws; int G = G0, bx = (int)MISC[12]; bx = __builtin_amdgcn_readfirstlane(bx); unsigned ldsb = (unsigned)(size_t)lds0; asm volatile("" : "+s"(G), "+s"(bx), "+s"(ldsb)); LAS unsigned char* lds = (LAS unsigned char*)(size_t)ldsb; const int vb = (G % 8 == 0) ? (bx % 8) * (G / 8) + bx / 8 : bx; (void)lane; (void)wave; (void)ws; (void)vb; (void)lds
#define SEAM(k) do { if (!MK_PER_PHASE && IN(k) && IN((k) + 1)) xcd_barrier(bar); } while (0)
    if (IN(0)) { for (int rep = 0; rep < NREP(0); ++rep) { OPAQUE_TID(); p0_prologue(launder(AP), lds, tid, lane, wave, vb, G); if (rep + 1 < NREP(0)) xcd_barrier(bar); } } SEAM(0);
    if (!MK_PER_PHASE && IN(0) && IN(1)) {
        if (tid0 == 0) { unsigned* cen = (unsigned*)(ws0 + WS_CTL) + CW_CENS; const unsigned x = MISC[10], rank = MISC[11]; unsigned nx = 0, xi = 0, n0 = 0; bool eq = true;
            for (unsigned j = 0; j < 16; ++j) { const unsigned c = xb_ld(cen + 64 * j); if (c) { if (!nx) n0 = c; eq = eq && (c == n0); xi += (j < x) ? 1u : 0u; ++nx; } }
            if (nx == 8 && eq && 8 * n0 == (unsigned)G0 && rank < n0) MISC[12] = rank * 8 + xi; }
        __syncthreads();
    }
    for (int l = 0; l < DEPTH; ++l) {
        const int p = 1 + 8 * l;
        if (IN(p + 0)) { for (int rep = 0; rep < NREP(p + 0); ++rep) { OPAQUE_TID(); pg8::Gemm g{(const bf16*)(ws + WS_XB), (const bf16*)(ws + WS_WIN + l * WIN_L), MTOT, INW, DM}; const int Gg = gemm_cus((MTOT / 256) * (INW / 256), G); pg8::StaticOrder S; S.init(MTOT, INW, Gg, bx, DM, WGM_G1);
            pg8::EpiRowScaleBf16 E{(bf16*)(ws + WS_R1), INW, (const float*)(ws + WS_RINV), (float*)(ws + WS_VPART), O5 / 256}; if (bx < Gg) pg8::gemm_phase<pg8::EpiRowScaleBf16, pg8::StaticOrder, true, true>(lds + RING_OFF, g, S, E, tid);
            if (bx >= Gg || Gg == G) conv_helper(launder(AP), ws, lds, 0, l, Gg == G ? bx : bx - Gg, Gg == G ? G : G - Gg, lane, wave); if (rep + 1 < NREP(p + 0)) xcd_barrier(bar); } } SEAM(p + 0);
        if (IN(p + 1)) { for (int rep = 0; rep < NREP(p + 1); ++rep) { OPAQUE_TID(); phase_mixers(launder(AP), l, lds, tid, lane, wave, vb, G); if (rep + 1 < NREP(p + 1)) xcd_barrier(bar); } } SEAM(p + 1);
        if (IN(p + 2)) { for (int rep = 0; rep < NREP(p + 2); ++rep) { OPAQUE_TID(); pg8::Gemm g{(const bf16*)(ws + WS_R2), (const bf16*)(ws + WS_WOUT + l * WOUT_L), MTOT, DM, DM}; pg8::SplitTailOrder S; S.init(MTOT, DM, G, bx, DM, NS2, WGM_G2);
            const int nsl = S.ns > 1 ? S.ntail * S.ns : G; pg8::EpiMixTile E{(bf16*)(ws + WS_MIX), DM, (float*)(ws + WS_PART)};
            if (bx >= nsl || nsl == G) { conv_helper(launder(AP), ws, lds, 1, l, nsl == G ? bx : bx - nsl, nsl == G ? G : G - nsl, lane, wave); __syncthreads(); }
            pg8::gemm_phase<pg8::EpiMixTile, pg8::SplitTailOrder, true, true>(lds + RING_OFF, g, S, E, tid); if (rep + 1 < NREP(p + 2)) xcd_barrier(bar); } } SEAM(p + 2);
        if (IN(p + 3)) { for (int rep = 0; rep < NREP(p + 3); ++rep) { OPAQUE_TID(); phase_postnorm(launder(AP), AP->g_mix_post + l * DM, l == 0, false, DM, NS2, WGM_G2, lane, wave, vb, G); if (rep + 1 < NREP(p + 3)) xcd_barrier(bar); } } SEAM(p + 3);
        if (PROBE_LEAK && l == 0) { if (blockIdx.x == 0 && tid0 == 0) { MISC[16] = (unsigned)__builtin_amdgcn_s_memtime(); MISC[17] = (unsigned)__builtin_amdgcn_s_memrealtime(); } }
        if (IN(p + 4)) { for (int rep = 0; rep < NREP(p + 4); ++rep) { OPAQUE_TID(); pg8::Gemm g{(const bf16*)(ws + WS_XB), (const bf16*)(ws + WS_WUP + l * WUP_L), MTOT, FF2, DM}; const int Gg = (l + 1 < DEPTH || G3_LAST_CUS == 0) ? gemm_cus((MTOT / 256) * (FF2 / 256), G) : (G3_LAST_CUS < G ? G3_LAST_CUS : G); pg8::StaticOrder S; S.init(MTOT, FF2, Gg, bx, DM, WGM_G3);
            EpiGateConvGelu E{launder(AP), ws, l, (LAS float*)(lds + XCH_OFF)}; if (bx < Gg) pg8::gemm_phase<EpiGateConvGelu, pg8::StaticOrder, true, true>(lds + RING_OFF, g, S, E, tid);
            if (l + 1 < DEPTH && (bx >= Gg || Gg == G)) conv_helper(launder(AP), ws, lds, 2, l, Gg == G ? bx : bx - Gg, Gg == G ? G : G - Gg, lane, wave); if (rep + 1 < NREP(p + 4)) xcd_barrier(bar); } } SEAM(p + 4);
        if (PROBE_LEAK && l == 0) { if (blockIdx.x == 0 && tid0 == 0) { MISC[18] = (unsigned)__builtin_amdgcn_s_memtime() - MISC[16]; MISC[19] = (unsigned)__builtin_amdgcn_s_memrealtime() - MISC[17]; } }
        if (PROBE_NULL && l == 0) { OPAQUE_TID(); xcd_barrier(bar);
            const int N_ = PROBE_NULL == 1 ? INW : (PROBE_NULL == 3 ? FF2 : DM), K_ = PROBE_NULL == 4 ? FF : DM;
            const bf16* A_ = (const bf16*)(ws + ((PROBE_NULL == 1 || PROBE_NULL == 3) ? WS_XB : WS_R2)); const bf16* B_ = (const bf16*)(ws + (PROBE_NULL == 1 ? WS_WIN : PROBE_NULL == 2 ? WS_WOUT : PROBE_NULL == 3 ? WS_WUP : WS_WDN));
            pg8::Gemm g{A_, B_, MTOT, N_, K_}; EpiNull E{};
            if (PROBE_NULL == 6) { SameUnitOrder S{2, 88}; pg8::Gemm g6{(const bf16*)(ws + WS_R2), (const bf16*)(ws + WS_WDN), MTOT, DM, FF}; pg8::gemm_phase<EpiNull, SameUnitOrder, true, true>(lds + RING_OFF, g6, S, E, tid); }
            else if (PROBE_NULL == 7) { pg8::SplitTailOrder S; S.init(MTOT, DM, G, bx, FF, NSPLIT); pg8::Gemm g7{(const bf16*)(ws + WS_R2), (const bf16*)(ws + WS_WDN), MTOT, DM, FF}; pg8::gemm_phase<EpiNull, pg8::SplitTailOrder, true, true>(lds + RING_OFF, g7, S, E, tid); }
            else if (PROBE_NULL == 5) { SameUnitOrder S{7, 32}; pg8::Gemm g5{(const bf16*)(ws + WS_XB), (const bf16*)(ws + WS_WUP), MTOT, FF2, DM}; pg8::gemm_phase<EpiNull, SameUnitOrder, true, true>(lds + RING_OFF, g5, S, E, tid); }
            else { pg8::StaticOrder S; S.init(MTOT, N_, G, bx, K_); pg8::gemm_phase<EpiNull, pg8::StaticOrder, true, true>(lds + RING_OFF, g, S, E, tid); }
            xcd_barrier(bar); }
        if (IN(p + 5)) { for (int rep = 0; rep < NREP(p + 5); ++rep) { OPAQUE_TID(); phase_halofix(launder(AP), l, tid, vb, G); if (rep + 1 < NREP(p + 5)) xcd_barrier(bar); } } SEAM(p + 5);
        if (IN(p + 6)) { for (int rep = 0; rep < NREP(p + 6); ++rep) { OPAQUE_TID(); pg8::Gemm g{(const bf16*)(ws + WS_R2), (const bf16*)(ws + WS_WDN + l * WDN_L), MTOT, DM, FF}; pg8::SplitTailOrder S; S.init(MTOT, DM, G, bx, FF, NSPLIT, WGM_G4);
            pg8::EpiMixTile E{(bf16*)(ws + WS_MIX), DM, (float*)(ws + WS_PART)}; pg8::gemm_phase<pg8::EpiMixTile, pg8::SplitTailOrder, true, true>(lds + RING_OFF, g, S, E, tid); if (rep + 1 < NREP(p + 6)) xcd_barrier(bar); } } SEAM(p + 6);
        if (IN(p + 7)) { for (int rep = 0; rep < NREP(p + 7); ++rep) { OPAQUE_TID(); phase_postnorm(launder(AP), AP->g_ffn_post + l * DM, false, l + 1 == DEPTH, FF, NSPLIT, WGM_G4, lane, wave, vb, G); if (rep + 1 < NREP(p + 7)) xcd_barrier(bar); } } SEAM(p + 7);
    }
    if (PROBE_LEAK) { if (blockIdx.x == 0 && tid0 == 0) { const float cyc = (float)MISC[18], rt = (float)MISC[19]; const float v = PROBE_LEAK == 1 ? cyc / rt * 100.f   : (PROBE_LEAK == 2 ? rt * 0.01f   : cyc * (1.f / 224.f)  ); AP->out[OUT_VS] = 32.f * floorf((v - (float)PROBE_BASE) * (1.f / 32.f) + 0.5f) + 1000.f;     } }
#undef IN
#undef SEAM
}

extern "C" void kernel_launch(void* const* d_in, const int* in_sizes, int n_in, void* d_out, int out_size, void* d_ws, size_t ws_size, hipStream_t stream) {
    static int grid = 0;
    if (grid == 0) {
        if (n_in != 21 || out_size != (int)OUT_END || ws_size < WS_END) { fprintf(stderr, "kernel_launch: unexpected sizes n_in %d out %d ws %zu (need %zu)\n", n_in, out_size, ws_size, (size_t)WS_END); grid = -1; return; }
        int dev = 0, cus = 0, per_cu = 0;
        if (hipGetDevice(&dev) != hipSuccess || hipDeviceGetAttribute(&cus, hipDeviceAttributeMultiprocessorCount, dev) != hipSuccess) { grid = -1; return; }
        if (hipFuncSetAttribute((const void*)mk_fwd, hipFuncAttributeMaxDynamicSharedMemorySize, LDS_BYTES) != hipSuccess) { fprintf(stderr, "kernel_launch: hipFuncSetAttribute failed\n"); grid = -1; return; }
        if (hipOccupancyMaxActiveBlocksPerMultiprocessor(&per_cu, (const void*)mk_fwd, NTHR, LDS_BYTES) != hipSuccess || per_cu < 1) { fprintf(stderr, "kernel_launch: occupancy query says %d blocks per CU\n", per_cu); (void)hipGetLastError(); grid = -1; return; }
        grid = cus;
    }
    if (grid < 0) return;
    if (hipMemsetAsync((char*)d_ws + WS_CTL, 0, CTL_ZERO_BYTES, stream) != hipSuccess) { fprintf(stderr, "kernel_launch: memset failed\n"); return; }
    Args a{};
    const float** ap = (const float**)&a;
    for (int i = 0; i < 21; ++i) ap[i] = (const float*)d_in[i];
    a.out = (float*)d_out; a.ws = (unsigned char*)d_ws;
#if MK_PER_PHASE
    for (int p = 0; p < NPHASE; ++p) { a.ph_lo = p; a.ph_hi = p + 1; hipLaunchKernelGGL(mk_fwd, dim3(grid), dim3(NTHR), LDS_BYTES, stream, a); }
#else
    a.ph_lo = 0; a.ph_hi = NPHASE;
#if MK_COOP_LAUNCH
    void* kargs[] = {&a};
    hipError_t e = hipLaunchCooperativeKernel((const void*)mk_fwd, dim3(grid), dim3(NTHR), kargs, LDS_BYTES, stream);
    if (e != hipSuccess) fprintf(stderr, "kernel_launch: cooperative launch failed: %s (grid %d)\n", hipGetErrorString(e), grid);
#else
    hipLaunchKernelGGL(mk_fwd, dim3(grid), dim3(NTHR), LDS_BYTES, stream, a);
    hipError_t e = hipPeekAtLastError(); if (e != hipSuccess) fprintf(stderr, "kernel_launch: launch failed: %s (grid %d)\n", hipGetErrorString(e), grid);
#endif
#endif
}
```
